# Optimizing an MI355X kernel written in HIP

```python
import jax, jax.numpy as jnp
from jax import lax
import numpy as np

D_MODEL = 1024
BATCH = 8
SEQ = 2048
DEPTH = 2

MEM_TOKENS = 256
HEAD_DIM = 64
CONV_CH = 3 * D_MODEL // 8
N_DIL_HEADS = (3 * D_MODEL // 8) // HEAD_DIM
N_MEM_HEADS = 4
DIL_WIDTH = N_DIL_HEADS * HEAD_DIM
MEM_WIDTH = N_MEM_HEADS * HEAD_DIM
MIX_WIDTH = CONV_CH + DIL_WIDTH + MEM_WIDTH
IN_SPLITS = [CONV_CH, 2 * CONV_CH, 3 * CONV_CH,
             3 * CONV_CH + DIL_WIDTH, 3 * CONV_CH + 2 * DIL_WIDTH, 3 * CONV_CH + 3 * DIL_WIDTH]
IN_PROJ_WIDTH = 3 * CONV_CH + 3 * DIL_WIDTH + MEM_WIDTH
CONV_KSIZE = 3
DILATED_PATTERNS = ((128, 1), (512, 4), (2048, 16))
N_EXPERTS = 16
D_FF = 2 * D_MODEL
EC_CAPACITY = 2
RMS_EPS = 1e-6
NEG_INF = -1e30

kernel_name = "hybrid_conv_dilattn_mem_ecmoe_encoder"


def rmsnorm(x, g):
    xf = x.astype(jnp.float32)
    y = xf * lax.rsqrt(jnp.mean(xf * xf, axis=-1, keepdims=True) + RMS_EPS)
    return (y * g.astype(jnp.float32)).astype(x.dtype)


def alibi_slopes(n):
    return jnp.asarray([2.0 ** (-8.0 * (h + 1) / n) for h in range(n)], dtype=jnp.float32)


def split_heads(t, n):
    b, s, _ = t.shape
    return t.reshape(b, s, n, HEAD_DIM).transpose(0, 2, 1, 3)


def merge_heads(t):
    b, h, s, d = t.shape
    return t.transpose(0, 2, 1, 3).reshape(b, s, h * d)


def short_conv_mixer(xc, b_gate, c_gate, conv_w):
    s = xc.shape[1]
    u = c_gate * xc
    up = jnp.pad(u, ((0, 0), (1, 1), (0, 0)))
    conv = conv_w[0] * up[:, :s] + conv_w[1] * up[:, 1:s + 1] + conv_w[2] * up[:, 2:]
    return b_gate * conv


def dilated_branch(q, k, v, slopes, window, dil):
    bsz, h, s, hd = q.shape
    half = window // (2 * dil)
    L = s // dil
    nb = -(-L // half)
    Lp = nb * half

    def to_res(t):
        return t.reshape(bsz, h, L, dil, hd).transpose(0, 1, 3, 2, 4)

    qr, kr, vr = to_res(q), to_res(k), to_res(v)
    qr = jnp.pad(qr, ((0, 0), (0, 0), (0, 0), (0, Lp - L), (0, 0)))
    pad_k = ((0, 0), (0, 0), (0, 0), (half, Lp - L + half), (0, 0))
    kr, vr = jnp.pad(kr, pad_k), jnp.pad(vr, pad_k)
    qb = qr.reshape(bsz, h, dil, nb, half, hd)

    def band(t):
        tb = t.reshape(bsz, h, dil, nb + 2, half, hd)
        return jnp.concatenate([tb[:, :, :, :-2], tb[:, :, :, 1:-1], tb[:, :, :, 2:]], axis=4)

    kb, vb = band(kr), band(vr)
    scores = jnp.einsum('bhrnqd,bhrnkd->bhrnqk', qb, kb) * (HEAD_DIM ** -0.5)
    qi = jnp.arange(nb)[:, None, None] * half + jnp.arange(half)[None, :, None]
    kj = jnp.arange(nb)[:, None, None] * half - half + jnp.arange(3 * half)[None, None, :]
    rel = kj - qi
    valid = (jnp.abs(rel) <= half) & (kj >= 0) & (kj < L)
    dist = (jnp.abs(rel) * dil).astype(jnp.float32)
    bias = -slopes[:, None, None, None] * dist[None]
    scores = jnp.where(valid[None, None, None], scores + bias[None, :, None], NEG_INF)
    m = jnp.max(scores, axis=-1, keepdims=True)
    p = jnp.exp(scores - m)
    l = jnp.sum(p, axis=-1, keepdims=True)
    o = jnp.einsum('bhrnqk,bhrnkd->bhrnqd', p, vb) / l
    lse = (m + jnp.log(l))[..., 0]
    o = o.reshape(bsz, h, dil, Lp, hd)[:, :, :, :L].transpose(0, 1, 3, 2, 4).reshape(bsz, h, s, hd)
    lse = lse.reshape(bsz, h, dil, Lp)[..., :L].transpose(0, 1, 3, 2).reshape(bsz, h, s)
    return o, lse


def dilated_attention(q, k, v, slopes):
    outs, lses = [], []
    for window, dil in DILATED_PATTERNS:
        o, lse = dilated_branch(q, k, v, slopes, window, dil)
        outs.append(o)
        lses.append(lse)
    w = jax.nn.softmax(jnp.stack(lses, axis=0), axis=0)
    return jnp.sum(w[..., None] * jnp.stack(outs, axis=0), axis=0)


def memory_attention(qm, km, vm):
    scores = jnp.einsum('bhqd,bhkd->bhqk', qm.astype(jnp.float32), km.astype(jnp.float32)) * (HEAD_DIM ** -0.5)
    p = jax.nn.softmax(scores, axis=-1)
    return jnp.einsum('bhqk,bhkd->bhqd', p, vm.astype(jnp.float32))


def parallel_mixer(xn, mem_n, w_in, conv_w, w_mem_kv, w_out, slopes):
    h = xn @ w_in
    xc, bg, cg, q, k, v, qm = jnp.split(h, IN_SPLITS, axis=-1)
    conv_out = short_conv_mixer(xc, bg, cg, conv_w)
    f32 = jnp.float32
    dil = dilated_attention(split_heads(q, N_DIL_HEADS).astype(f32),
                            split_heads(k, N_DIL_HEADS).astype(f32),
                            split_heads(v, N_DIL_HEADS).astype(f32), slopes)
    dil_out = merge_heads(dil).astype(xn.dtype)
    km, vm = jnp.split(mem_n @ w_mem_kv, 2, axis=-1)
    mo = memory_attention(split_heads(qm, N_MEM_HEADS), split_heads(km, N_MEM_HEADS),
                          split_heads(vm, N_MEM_HEADS))
    mem_out = merge_heads(mo).astype(xn.dtype)
    return jnp.concatenate([conv_out, dil_out, mem_out], axis=-1) @ w_out


def expert_choice_ffn(xn, w_router, w_gate, w_up, w_down):
    bsz, s, d = xn.shape
    cap = EC_CAPACITY * s // N_EXPERTS
    aff = jax.nn.softmax((xn @ w_router).astype(jnp.float32), axis=-1)
    g, idx = lax.top_k(aff.transpose(0, 2, 1), cap)
    xg = jax.vmap(lambda xb, ib: xb[ib])(xn, idx)
    hid = jax.nn.silu(jnp.einsum('becd,edf->becf', xg, w_gate)) * jnp.einsum('becd,edf->becf', xg, w_up)
    y = jnp.einsum('becf,efd->becd', hid, w_down) * g[..., None].astype(xn.dtype)
    return jax.vmap(lambda yb, ib: jax.ops.segment_sum(yb.reshape(-1, d), ib.reshape(-1), num_segments=s))(y, idx)


def setup_inputs(seed: int = 0) -> dict:
    key = jax.random.key(seed)
    ks = jax.random.split(key, 14)
    f32 = jnp.float32
    D, L, E, F = D_MODEL, DEPTH, N_EXPERTS, D_FF
    nrm = lambda k, shape, scale: (jax.random.normal(k, shape, f32) * scale).astype(f32)
    return {
        "x": nrm(ks[0], (BATCH, SEQ, D), 1.0),
        "mem": nrm(ks[1], (BATCH, MEM_TOKENS, D), 1.0),
        "mem_norm": 1.0 + nrm(ks[2], (D,), 0.02),
        "norm_mix": 1.0 + nrm(ks[3], (L, D), 0.02),
        "w_in": nrm(ks[4], (L, D, IN_PROJ_WIDTH), D ** -0.5),
        "conv_w": nrm(ks[5], (L, CONV_KSIZE, CONV_CH), 0.5),
        "w_mem_kv": nrm(ks[6], (L, D, 2 * MEM_WIDTH), D ** -0.5),
        "w_out": nrm(ks[7], (L, MIX_WIDTH, D), MIX_WIDTH ** -0.5),
        "norm_ffn": 1.0 + nrm(ks[8], (L, D), 0.02),
        "w_router": nrm(ks[9], (L, D, E), D ** -0.5),
        "w_gate": nrm(ks[10], (L, E, D, F), D ** -0.5),
        "w_up": nrm(ks[11], (L, E, D, F), D ** -0.5),
        "w_down": nrm(ks[12], (L, E, F, D), F ** -0.5),
        "norm_final": 1.0 + nrm(ks[13], (D,), 0.02),
    }


def reference(x, mem, mem_norm, norm_mix, w_in, conv_w, w_mem_kv, w_out, norm_ffn,
              w_router, w_gate, w_up, w_down, norm_final):
    slopes = alibi_slopes(N_DIL_HEADS)
    mem_n = rmsnorm(mem, mem_norm)
    for l in range(DEPTH):
        x = x + parallel_mixer(rmsnorm(x, norm_mix[l]), mem_n, w_in[l], conv_w[l],
                               w_mem_kv[l], w_out[l], slopes)
        x = x + expert_choice_ffn(rmsnorm(x, norm_ffn[l]), w_router[l], w_gate[l], w_up[l], w_down[l])
    return rmsnorm(x, norm_final)
```

```cpp
#include <hip/hip_runtime.h>
#include <cstdio>
#include <cstdint>
#include <cmath>
#include <type_traits>

#ifndef ONE_LAUNCH
#define ONE_LAUNCH 1
#endif
#ifndef ROUTER_MFMA
#define ROUTER_MFMA 1
#endif
#ifndef SKIPMASK
#define SKIPMASK 0
#endif
#define SK(b) (!((SKIPMASK) & (b)))
#ifndef DUPMASK
#define DUPMASK 0
#endif
#define NREP(b) (((DUPMASK) & (b)) ? 2 : 1)

#define GAS __attribute__((address_space(1)))
#define LAS __attribute__((address_space(3)))
#define CAS __attribute__((address_space(4)))
typedef unsigned short bf16;
typedef unsigned v4u __attribute__((ext_vector_type(4)));
typedef unsigned v2u __attribute__((ext_vector_type(2)));
typedef float f32x4 __attribute__((ext_vector_type(4)));
typedef float f32x16 __attribute__((ext_vector_type(16)));
typedef short bf16x8 __attribute__((ext_vector_type(8)));
typedef short s16x4 __attribute__((ext_vector_type(4)));

constexpr int NB = 8, SEQ = 2048, DM = 1024, NLAYER = 2, MEMT = 256, INW = 2560;
constexpr int T = NB * SEQ;
constexpr int C_XC = 0, C_BG = 384, C_CG = 768, C_Q = 1152, C_K = 1536, C_V = 1920, C_QM = 2304;
constexpr int NDH = 6, NMH = 4, CONVC = 384;
constexpr int NE = 16, FF = 2048, CAP = 256, ER = NB * CAP;
constexpr float RMS_EPS = 1e-6f;
constexpr float LOG2E = 1.4426950408889634f;

constexpr size_t MiB = 1u << 20;
constexpr size_t WS_CTL = 0, CTL_ZERO_BYTES = 1 * MiB;
constexpr size_t WS_WIN = 2 * MiB;
constexpr size_t WS_WKV = 12 * MiB;
constexpr size_t WS_WOUT = 14 * MiB;
constexpr size_t WS_WGU = 18 * MiB;
constexpr size_t WS_WDN = 274 * MiB;
constexpr size_t WS_XB = 402 * MiB;
constexpr size_t WS_H = 434 * MiB;
constexpr size_t WS_OP = 514 * MiB;
constexpr size_t WS_LSE = 550 * MiB;
constexpr size_t WS_MIX = 552 * MiB;
constexpr size_t WS_MEMN = 584 * MiB;
constexpr size_t WS_KVM = 588 * MiB;
constexpr size_t WS_AFFT = 592 * MiB;
constexpr size_t WS_INV = 593 * MiB;
constexpr size_t WS_GROW = 594 * MiB;
constexpr size_t WS_IDX = 595 * MiB;
constexpr size_t WS_XG = 596 * MiB;
constexpr size_t WS_HID = 660 * MiB;
constexpr size_t WS_X1B = 788 * MiB;
constexpr size_t WS_RS0 = 820 * MiB;
constexpr size_t WS_SS1 = 821 * MiB;
constexpr size_t WS_RS1 = 823 * MiB;
constexpr size_t WS_RSLOT = 824 * MiB;
constexpr size_t WS_X1F8 = 825 * MiB;
constexpr size_t WS_END = 841 * MiB;

constexpr int CW_BAR = 4096;
#define XCD_BAR_WORDS 3456
constexpr int MAX_LAUNCH = 24;
static_assert((CW_BAR + MAX_LAUNCH * XCD_BAR_WORDS) * 4 <= (int)CTL_ZERO_BYTES, "ctl");

constexpr int RING_BYTES = 131072, LDSCTL_OFF = 155648  , MISC_OFF = LDSCTL_OFF + 320, LDSX_OFF = LDSCTL_OFF + 4096  , LDS_BYTES = 163840  ;
constexpr int NWAVES = 8;

#define RLX_AGENT __ATOMIC_RELAXED, __HIP_MEMORY_SCOPE_AGENT
#define LDS_WAIT() asm volatile("s_waitcnt lgkmcnt(0)" ::: "memory")
__device__ __forceinline__ unsigned f2bf(float f) { unsigned u = __builtin_bit_cast(unsigned, f); return (u + 0x7fffu + ((u >> 16) & 1u)) >> 16; }
__device__ __forceinline__ unsigned pk2(float lo, float hi) { return f2bf(lo) | (f2bf(hi) << 16); }
__device__ __forceinline__ unsigned cvtpk_s(float lo, float hi) { typedef float f2 __attribute__((ext_vector_type(2))); typedef __bf16 b2 __attribute__((ext_vector_type(2))); f2 v = {lo, hi}; b2 b = __builtin_convertvector(v, b2); return __builtin_bit_cast(unsigned, b); }
__device__ __forceinline__ float bflo(unsigned w) { return __builtin_bit_cast(float, w << 16); }
__device__ __forceinline__ float bfhi(unsigned w) { return __builtin_bit_cast(float, w & 0xffff0000u); }
__device__ __forceinline__ float bf2f(bf16 v) { return __builtin_bit_cast(float, (unsigned)v << 16); }
__device__ __forceinline__ float wave_sum(float v) {
#pragma unroll
    for (int o = 1; o < 64; o <<= 1) v += __shfl_xor(v, o);
    return v;
}

namespace pg8 {
#define PG8_LAS __attribute__((address_space(3)))
typedef unsigned short bf16_t;
typedef short bf16x8 __attribute__((ext_vector_type(8)));
typedef float f32x4 __attribute__((ext_vector_type(4)));
typedef unsigned u32x4 __attribute__((ext_vector_type(4)));
typedef unsigned u32x2 __attribute__((ext_vector_type(2)));
constexpr int BM = 256, BK = 64, HALF = 128, HTB = HALF * BK * 2  , STAGE_BYTES = 8 * HTB, NXCD = 8, WGM = 8;

__host__ __device__ __forceinline__ int lds_byte(int r, int c) { const int st = (r >> 4) * 2 + (c >> 5), rr = r & 15, cc = c & 31, ob = rr * 64 + cc * 2; return st * 1024 + (ob ^ (((ob >> 9) & 1) << 5)); }
__host__ __device__ __forceinline__ void stage_rc(int b, int& R, int& C) { const int st = b / 1024, sb = b % 1024, swz = sb ^ (((sb >> 9) & 1) << 5); R = (st >> 1) * 16 + swz / 64; C = (st & 1) * 32 + (swz % 64) / 2; }
__host__ __device__ __forceinline__ int perm32(int rho) { const int n = rho >> 4, i = rho & 15; return 8 * (i >> 2) + 4 * n + (i & 3); }

typedef int i32x4 __attribute__((ext_vector_type(4)));
typedef int i32x8 __attribute__((ext_vector_type(8)));
__device__ __forceinline__ i32x8 cat8(bf16x8 a, bf16x8 b) { const i32x4 x = __builtin_bit_cast(i32x4, a), y = __builtin_bit_cast(i32x4, b); return __builtin_shufflevector(x, y, 0, 1, 2, 3, 4, 5, 6, 7); }
__device__ __forceinline__ unsigned pk4_e4m3(float a, float b, float c, float d) {
    a = __builtin_amdgcn_fmed3f(a, -448.f, 448.f); b = __builtin_amdgcn_fmed3f(b, -448.f, 448.f); c = __builtin_amdgcn_fmed3f(c, -448.f, 448.f); d = __builtin_amdgcn_fmed3f(d, -448.f, 448.f);
    int w = __builtin_amdgcn_cvt_pk_fp8_f32(a, b, 0, false); w = __builtin_amdgcn_cvt_pk_fp8_f32(c, d, w, true); return (unsigned)w; }
__device__ __forceinline__ void mfma8(f32x4& acc, i32x8 a, i32x8 b) { asm volatile("v_mfma_f32_16x16x128_f8f6f4 %0, %1, %2, %0" : "+v"(acc) : "v"(a), "v"(b)); }
struct Unit { int pm, pn; };
struct Gemm { const bf16_t* A; const bf16_t* Bt; int M, N, K; int gm; size_t gstride; const int* aidx; };

struct StaticOrder {
    int nM, nN, nwg, G, c;
    __host__ __device__ void init(int M, int N, int G_, int c_) { nM = M / BM; nN = N / BM; nwg = nM * nN; G = G_; c = c_; }
    __host__ __device__ bool next(int i, Unit& u) const {
        const long L = (long)i * G + c; if (L >= nwg) return false;
        int wgid = (int)L; { const int q = nwg / NXCD, r = nwg % NXCD, xcd = wgid % NXCD, off = wgid / NXCD; wgid = (xcd < r ? xcd * (q + 1) : r * (q + 1) + (xcd - r) * q) + off; }
        const int nig = WGM * nN, gid = wgid / nig, fm = gid * WGM, gsz = (nM - fm) < WGM ? (nM - fm) : WGM;
        u.pm = fm + ((wgid % nig) % gsz); u.pn = (wgid % nig) / gsz; return true;
    }
    __device__ __forceinline__ void a_ready(const Unit&) const {}
    __device__ __forceinline__ void done(const Unit&) const {}
};

struct ExpertOrder {
    int pm, pn0;
    __device__ __forceinline__ void init(int vcu) { pm = (vcu >> 4) * 8 + (vcu & 7); pn0 = ((vcu >> 3) & 1) * 8; }
    __device__ __forceinline__ bool next(int i, Unit& u) const { if (i >= 8) return false; u.pm = pm; u.pn = pn0 + i; return true; }
    __device__ __forceinline__ void a_ready(const Unit&) const {}
    __device__ __forceinline__ void done(const Unit&) const {}
};

__device__ __forceinline__ unsigned cvt_pk_bf16(float lo, float hi) { unsigned r; asm volatile("v_cvt_pk_bf16_f32 %0, %1, %2" : "=v"(r) : "v"(lo), "v"(hi)); return r; }

struct EpiBf16 {
    static constexpr bool PERM = true, AFTER_DRAIN = false;
    bf16_t* O; int ldc; const float* rscale;
    __device__ __forceinline__ void operator()(const f32x4 (&acc)[2][2][4][2], const Unit& u, int wr, int wc, int fr, int fq) const {
        int row0 = u.pm * BM + wr * 64 + fr; asm volatile("" : "+v"(row0));
        const int col0 = u.pn * BM + wc * 32 + 8 * fq;
#pragma unroll
        for (int ai = 0; ai < 2; ++ai)
#pragma unroll
            for (int m = 0; m < 4; ++m) { const int row = row0 + ai * HALF + m * 16; bf16_t* rowp = O + (size_t)row * ldc + col0;
                const float sc = rscale ? rscale[row] : 1.f;
#pragma unroll
                for (int bj = 0; bj < 2; ++bj) { const f32x4 v0 = acc[ai][bj][m][0] * sc, v1 = acc[ai][bj][m][1] * sc;
                    u32x4 w; w.x = cvt_pk_bf16(v0[0], v0[1]); w.y = cvt_pk_bf16(v0[2], v0[3]); w.z = cvt_pk_bf16(v1[0], v1[1]); w.w = cvt_pk_bf16(v1[2], v1[3]);
                    *(u32x4*)(rowp + bj * HALF) = w; } }
    }
};
struct EpiF8 {
    static constexpr bool PERM = true, AFTER_DRAIN = false;
    unsigned char* O; int ldc; const float* rscale;
    __device__ __forceinline__ void operator()(const f32x4 (&acc)[2][2][4][2], const Unit& u, int wr, int wc, int fr, int fq) const {
        int row0 = u.pm * BM + wr * 64 + fr; asm volatile("" : "+v"(row0));
        const int col0 = u.pn * BM + wc * 32 + 8 * fq;
#pragma unroll
        for (int ai = 0; ai < 2; ++ai)
#pragma unroll
            for (int m = 0; m < 4; ++m) { const int row = row0 + ai * HALF + m * 16; unsigned char* rowp = O + (size_t)row * ldc + col0;
                const float sc = rscale[row];
#pragma unroll
                for (int bj = 0; bj < 2; ++bj) { const f32x4 v0 = acc[ai][bj][m][0] * sc, v1 = acc[ai][bj][m][1] * sc;
                    u32x2 w; w.x = pk4_e4m3(v0[0], v0[1], v0[2], v0[3]); w.y = pk4_e4m3(v1[0], v1[1], v1[2], v1[3]);
                    *(u32x2*)(rowp + bj * HALF) = w; } }
    }
};
struct EpiResBf16 {
    static constexpr bool PERM = true, AFTER_DRAIN = false;
    const bf16_t* base; bf16_t* out; int ldc; float* ss; unsigned char* o8; float s8;
    __device__ __forceinline__ void operator()(const f32x4 (&acc)[2][2][4][2], const Unit& u, int wr, int wc, int fr, int fq) const {
        int row0 = u.pm * BM + wr * 64 + fr; asm volatile("" : "+v"(row0));
        const int col0 = u.pn * BM + wc * 32 + 8 * fq;
#pragma unroll
        for (int ai = 0; ai < 2; ++ai) {
            u32x4 b[4][2];
#pragma unroll
            for (int m = 0; m < 4; ++m)
#pragma unroll
                for (int bj = 0; bj < 2; ++bj) b[m][bj] = *(const u32x4*)(base + (size_t)(row0 + ai * HALF + m * 16) * ldc + col0 + bj * HALF);
#pragma unroll
            for (int m = 0; m < 4; ++m) { const int row = row0 + ai * HALF + m * 16; float q = 0.f;
#pragma unroll
                for (int bj = 0; bj < 2; ++bj) { const u32x4 bb = b[m][bj]; f32x4 v0 = acc[ai][bj][m][0], v1 = acc[ai][bj][m][1];
                    v0[0] += __builtin_bit_cast(float, bb.x << 16); v0[1] += __builtin_bit_cast(float, bb.x & 0xffff0000u); v0[2] += __builtin_bit_cast(float, bb.y << 16); v0[3] += __builtin_bit_cast(float, bb.y & 0xffff0000u);
                    v1[0] += __builtin_bit_cast(float, bb.z << 16); v1[1] += __builtin_bit_cast(float, bb.z & 0xffff0000u); v1[2] += __builtin_bit_cast(float, bb.w << 16); v1[3] += __builtin_bit_cast(float, bb.w & 0xffff0000u);
                    q += (v0[0] * v0[0] + v0[1] * v0[1]) + (v0[2] * v0[2] + v0[3] * v0[3]) + (v1[0] * v1[0] + v1[1] * v1[1]) + (v1[2] * v1[2] + v1[3] * v1[3]);
                    u32x4 w; w.x = cvt_pk_bf16(v0[0], v0[1]); w.y = cvt_pk_bf16(v0[2], v0[3]); w.z = cvt_pk_bf16(v1[0], v1[1]); w.w = cvt_pk_bf16(v1[2], v1[3]);
                    *(u32x4*)(out + (size_t)row * ldc + col0 + bj * HALF) = w;
                    if (o8) { u32x2 w8; w8.x = pk4_e4m3(v0[0] * s8, v0[1] * s8, v0[2] * s8, v0[3] * s8); w8.y = pk4_e4m3(v1[0] * s8, v1[1] * s8, v1[2] * s8, v1[3] * s8);
                        *(u32x2*)(o8 + (size_t)row * ldc + col0 + bj * HALF) = w8; } }
                q += __shfl_xor(q, 16); q += __shfl_xor(q, 32);
                if (fq == 0) ss[(size_t)row * 16 + 4 * u.pn + wc] = q; }
        }
    }
};
__device__ __forceinline__ float silu_mul(float g, float u) { return g * __builtin_amdgcn_rcpf(1.0f + __builtin_amdgcn_exp2f(-1.4426950408889634f * g)) * u; }
struct EpiSwiGLU {
    static constexpr bool PERM = true, AFTER_DRAIN = false;
    bf16_t* O; int ldc; const float* rscale;
    __device__ __forceinline__ void operator()(const f32x4 (&acc)[2][2][4][2], const Unit& u, int wr, int wc, int fr, int fq) const {
        int row0 = u.pm * BM + wr * 64 + fr; asm volatile("" : "+v"(row0));
        const int col0 = u.pn * HALF + wc * 32 + 8 * fq;
#pragma unroll
        for (int ai = 0; ai < 2; ++ai)
#pragma unroll
            for (int m = 0; m < 4; ++m) { const int row = row0 + ai * HALF + m * 16; bf16_t* rowp = O + (size_t)row * ldc + col0; const float sc = rscale[row];
                const f32x4 g0 = acc[ai][0][m][0] * sc, g1 = acc[ai][0][m][1] * sc, u0 = acc[ai][1][m][0] * sc, u1 = acc[ai][1][m][1] * sc;
                u32x4 w; w.x = cvt_pk_bf16(silu_mul(g0[0], u0[0]), silu_mul(g0[1], u0[1])); w.y = cvt_pk_bf16(silu_mul(g0[2], u0[2]), silu_mul(g0[3], u0[3]));
                w.z = cvt_pk_bf16(silu_mul(g1[0], u1[0]), silu_mul(g1[1], u1[1])); w.w = cvt_pk_bf16(silu_mul(g1[2], u1[2]), silu_mul(g1[3], u1[3]));
                *(u32x4*)rowp = w; }
    }
};

struct EpiSwiGLU8 {
    static constexpr bool PERM = true, AFTER_DRAIN = false;
    unsigned char* O; int ldc; const float* rscale; float oscale;
    __device__ __forceinline__ void operator()(const f32x4 (&acc)[2][2][4][2], const Unit& u, int wr, int wc, int fr, int fq) const {
        int row0 = u.pm * BM + wr * 64 + fr; asm volatile("" : "+v"(row0));
        const int col0 = u.pn * HALF + wc * 32 + 8 * fq;
#pragma unroll
        for (int ai = 0; ai < 2; ++ai)
#pragma unroll
            for (int m = 0; m < 4; ++m) { const int row = row0 + ai * HALF + m * 16; unsigned char* rowp = O + (size_t)row * ldc + col0; const float sc = rscale[row], su = sc * oscale;
                const f32x4 g0 = acc[ai][0][m][0] * sc, g1 = acc[ai][0][m][1] * sc, u0 = acc[ai][1][m][0] * su, u1 = acc[ai][1][m][1] * su;
                u32x2 w; w.x = pk4_e4m3(silu_mul(g0[0], u0[0]), silu_mul(g0[1], u0[1]), silu_mul(g0[2], u0[2]), silu_mul(g0[3], u0[3]));
                w.y = pk4_e4m3(silu_mul(g1[0], u1[0]), silu_mul(g1[1], u1[1]), silu_mul(g1[2], u1[2]), silu_mul(g1[3], u1[3]));
                *(u32x2*)rowp = w; }
    }
};

template <class Epi, class Sched, bool ALIGN_EPI = false, bool SP2 = false, bool GATHER = false, bool FP8 = false>
__device__ __forceinline__ void gemm_phase(PG8_LAS unsigned char* lds, const Gemm g, const Sched& S, const Epi& E) {
    int tid_ = threadIdx.x; asm volatile("" : "+v"(tid_));
    const int tid = tid_, wid = __builtin_amdgcn_readfirstlane(tid >> 6), lane = tid & 63, wr = wid >> 2, wc = wid & 3, fr = lane & 15, fq = lane >> 4;
    const int K = g.K, nt = K / BK;
    unsigned voffA[2], voffA1[2], voffB[2];
    const size_t hstep = (size_t)HALF * K * 2;
    Unit cur, nxt; int ui = 0;
    if (!S.next(0, cur)) return;
#pragma unroll
    for (int i = 0; i < 2; ++i) { int R, C; stage_rc(tid * 16 + i * 8192, R, C); const int Rb = Epi::PERM ? ((R & ~31) + perm32(R & 31)) : R;
        if constexpr (GATHER) { const int r0 = g.aidx[cur.pm * BM + R], r1 = g.aidx[cur.pm * BM + HALF + R]; voffA[i] = (unsigned)(r0 * K + C) * 2u; voffA1[i] = (unsigned)(r1 * K + C) * 2u; }
        else { voffA[i] = (unsigned)(R * K + C) * 2u; voffA1[i] = voffA[i] + (unsigned)hstep; }
        voffB[i] = (unsigned)(Rb * K + C) * 2u; }
    const size_t kstep = (size_t)(BK * 2);
    const size_t tstep = 2 * hstep;
    const size_t gbytes = g.gstride * 2;
    const unsigned ldsw = (unsigned)wid * 1024u;
    const int aoff = lds_byte(wr * 64 + fr, fq * 8), boff = lds_byte(wc * 32 + fr, fq * 8);
#define PG8_SA(b, h) (((b) * 2 + (h)) * HTB)
#define PG8_SB(b, h) ((4 + (b) * 2 + (h)) * HTB)
#define PG8_STAGE(bufoff, gbase, voff) do { _Pragma("unroll") for (int _i = 0; _i < 2; ++_i) \
        __builtin_amdgcn_global_load_lds((const unsigned*)((const char*)(gbase) + (voff)[_i]), (PG8_LAS unsigned*)(lds + (bufoff) + ldsw + _i * 8192), 16, 0, 0); } while (0)
#define PG8_LDA(dst, b, h) do { _Pragma("unroll") for (int m = 0; m < 4; ++m) _Pragma("unroll") for (int k = 0; k < 2; ++k) dst[m][k] = *(const PG8_LAS bf16x8*)(lds + PG8_SA(b, h) + aoff + m * 2048 + k * 1024); } while (0)
#define PG8_LDB(dst, b, h) do { _Pragma("unroll") for (int n = 0; n < 2; ++n) _Pragma("unroll") for (int k = 0; k < 2; ++k) dst[n][k] = *(const PG8_LAS bf16x8*)(lds + PG8_SB(b, h) + boff + n * 2048 + k * 1024); } while (0)
#define PG8_MMA(ai, bj, At, Bt) do { __builtin_amdgcn_s_setprio(1); \
        if constexpr (FP8) { _Pragma("unroll") for (int m = 0; m < 4; ++m) _Pragma("unroll") for (int n = 0; n < 2; ++n) \
            mfma8(acc[ai][bj][m][n], cat8(Bt[n][0], Bt[n][1]), cat8(At[m][0], At[m][1])); } \
        else { _Pragma("unroll") for (int m = 0; m < 4; ++m) _Pragma("unroll") for (int n = 0; n < 2; ++n) _Pragma("unroll") for (int k = 0; k < 2; ++k) \
            acc[ai][bj][m][n] = __builtin_amdgcn_mfma_f32_16x16x32_bf16(Bt[n][k], At[m][k], acc[ai][bj][m][n], 0, 0, 0); } \
        __builtin_amdgcn_s_setprio(0); } while (0)
#define PG8_WAIT_V(n) asm volatile("s_waitcnt vmcnt(" #n ")" ::: "memory")
#define PG8_WAIT_L(n) asm volatile("s_waitcnt lgkmcnt(" #n ")" ::: "memory")
#define PG8_BAR __builtin_amdgcn_s_barrier()
#define PG8_SCHED __builtin_amdgcn_sched_barrier(0)
    f32x4 acc[2][2][4][2];
#pragma unroll
    for (int a = 0; a < 2; ++a)
#pragma unroll
        for (int b = 0; b < 2; ++b)
#pragma unroll
            for (int m = 0; m < 4; ++m)
#pragma unroll
                for (int n = 0; n < 2; ++n) acc[a][b][m][n] = (f32x4){0.f, 0.f, 0.f, 0.f};
    bf16x8 At[4][2], B0[2][2], B1[2][2];
    const char* cA = (const char*)g.A + (GATHER ? (size_t)0 : (size_t)cur.pm * tstep); const char* cB = (const char*)g.Bt + (size_t)(cur.pm / g.gm) * gbytes + (size_t)cur.pn * tstep;
    S.a_ready(cur);
    if constexpr (SP2) {
        PG8_STAGE(PG8_SB(0, 0), cB, voffB); PG8_STAGE(PG8_SB(0, 1), cB + hstep, voffB); PG8_STAGE(PG8_SA(0, 0), cA, voffA); PG8_STAGE(PG8_SA(0, 1), cA, voffA1);
        if (wr == 1) PG8_BAR;
        PG8_WAIT_V(2); PG8_BAR;
        PG8_STAGE(PG8_SB(1, 0), cB + kstep, voffB); PG8_STAGE(PG8_SA(1, 0), cA + kstep, voffA); PG8_STAGE(PG8_SB(1, 1), cB + hstep + kstep, voffB);
        PG8_WAIT_V(6); PG8_BAR;
    } else {
        PG8_STAGE(PG8_SB(0, 0), cB, voffB); PG8_STAGE(PG8_SA(0, 0), cA, voffA); PG8_STAGE(PG8_SB(0, 1), cB + hstep, voffB); PG8_STAGE(PG8_SA(0, 1), cA, voffA1);
        if (wr == 1) PG8_BAR;
        PG8_WAIT_V(4); PG8_BAR;
        PG8_STAGE(PG8_SB(1, 0), cB + kstep, voffB); PG8_STAGE(PG8_SA(1, 0), cA + kstep, voffA); PG8_STAGE(PG8_SB(1, 1), cB + hstep + kstep, voffB);
        PG8_WAIT_V(6); PG8_BAR;
    }
    for (;;) {
        const bool has_next = S.next(ui + 1, nxt);
        const char* nA = (has_next && !GATHER) ? (const char*)g.A + (size_t)nxt.pm * tstep : cA; const char* nB = has_next ? (const char*)g.Bt + (size_t)(nxt.pm / g.gm) * gbytes + (size_t)nxt.pn * tstep : cB;
        for (int t = 0; t < nt; t += 2) {
            const bool last = (t == nt - 2);
            const char* a1 = cA + (size_t)(t + 1) * kstep;
            const char* a2 = last ? nA : cA + (size_t)(t + 2) * kstep; const char* b2 = last ? nB : cB + (size_t)(t + 2) * kstep;
            const char* a3 = a2 + kstep; const char* b3 = b2 + kstep;
            if (last && has_next) S.a_ready(nxt);
            if constexpr (SP2) {
            PG8_LDB(B0, 0, 0); PG8_LDB(B1, 0, 1); PG8_SCHED; PG8_LDA(At, 0, 0); PG8_STAGE(PG8_SA(1, 1), a1, voffA1);
            PG8_WAIT_V(8); PG8_WAIT_L(0); PG8_BAR; PG8_MMA(0, 0, At, B0); PG8_MMA(0, 1, At, B1); PG8_BAR; PG8_SCHED;
            PG8_LDA(At, 0, 1); PG8_STAGE(PG8_SB(0, 0), b2, voffB); PG8_STAGE(PG8_SB(0, 1), b2 + hstep, voffB); PG8_STAGE(PG8_SA(0, 0), a2, voffA);
            PG8_WAIT_V(8); PG8_WAIT_L(0); PG8_BAR; PG8_MMA(1, 0, At, B0); PG8_MMA(1, 1, At, B1); PG8_BAR; PG8_SCHED;
            PG8_LDB(B0, 1, 0); PG8_LDB(B1, 1, 1); PG8_SCHED; PG8_LDA(At, 1, 0); PG8_STAGE(PG8_SA(0, 1), a2, voffA1);
            PG8_WAIT_V(8); PG8_WAIT_L(0); PG8_BAR; PG8_MMA(0, 0, At, B0); PG8_MMA(0, 1, At, B1); PG8_BAR; PG8_SCHED;
            PG8_LDA(At, 1, 1); PG8_STAGE(PG8_SB(1, 0), b3, voffB); PG8_STAGE(PG8_SB(1, 1), b3 + hstep, voffB); PG8_STAGE(PG8_SA(1, 0), a3, voffA);
            PG8_WAIT_V(8); PG8_WAIT_L(0); PG8_BAR; PG8_MMA(1, 0, At, B0); PG8_MMA(1, 1, At, B1); PG8_BAR; PG8_SCHED;
            } else {
            PG8_LDB(B0, 0, 0); PG8_SCHED; PG8_LDA(At, 0, 0); PG8_STAGE(PG8_SA(1, 1), a1, voffA1);
            PG8_WAIT_L(8); PG8_BAR; PG8_WAIT_L(0); PG8_MMA(0, 0, At, B0); PG8_BAR; PG8_SCHED;
            PG8_LDB(B1, 0, 1); PG8_STAGE(PG8_SB(0, 0), b2, voffB);
            PG8_BAR; PG8_WAIT_L(0); PG8_MMA(0, 1, At, B1); PG8_BAR;
            PG8_LDA(At, 0, 1); PG8_STAGE(PG8_SA(0, 0), a2, voffA);
            PG8_BAR; PG8_WAIT_L(0); PG8_MMA(1, 0, At, B0); PG8_BAR; PG8_SCHED;
            PG8_STAGE(PG8_SB(0, 1), b2 + hstep, voffB);
            PG8_WAIT_V(6); PG8_BAR; PG8_MMA(1, 1, At, B1); PG8_BAR;
            PG8_LDB(B0, 1, 0); PG8_SCHED; PG8_LDA(At, 1, 0); PG8_STAGE(PG8_SA(0, 1), a2, voffA1);
            PG8_WAIT_L(8); PG8_BAR; PG8_WAIT_L(0); PG8_MMA(0, 0, At, B0); PG8_BAR; PG8_SCHED;
            PG8_LDB(B1, 1, 1); PG8_STAGE(PG8_SB(1, 0), b3, voffB);
            PG8_BAR; PG8_WAIT_L(0); PG8_MMA(0, 1, At, B1); PG8_BAR;
            PG8_LDA(At, 1, 1); PG8_STAGE(PG8_SA(1, 0), a3, voffA);
            PG8_BAR; PG8_WAIT_L(0); PG8_MMA(1, 0, At, B0); PG8_BAR; PG8_SCHED;
            PG8_STAGE(PG8_SB(1, 1), b3 + hstep, voffB);
            PG8_WAIT_V(6); PG8_BAR; PG8_MMA(1, 1, At, B1); PG8_BAR;
            }
        }
        if constexpr (FP8) asm volatile("s_nop 15\n\ts_nop 15" ::: "memory");
        if constexpr (ALIGN_EPI) { if (wr == 0) PG8_BAR; }
        if constexpr (!Epi::AFTER_DRAIN) { E(acc, cur, wr, wc, fr, fq); S.done(cur); }
        if (!has_next) break;
#pragma unroll
        for (int a = 0; a < 2; ++a)
#pragma unroll
            for (int b = 0; b < 2; ++b)
#pragma unroll
                for (int m = 0; m < 4; ++m)
#pragma unroll
                    for (int n = 0; n < 2; ++n) acc[a][b][m][n] = (f32x4){0.f, 0.f, 0.f, 0.f};
        cur = nxt; cA = nA; cB = nB; ++ui;
        if constexpr (ALIGN_EPI) { if (wr == 1) PG8_BAR; }
    }
    PG8_WAIT_V(0);
    if constexpr (!ALIGN_EPI) { if (wr == 0) PG8_BAR; }
    PG8_BAR;
#undef PG8_SA
#undef PG8_SB
#undef PG8_STAGE
#undef PG8_LDA
#undef PG8_LDB
#undef PG8_MMA
#undef PG8_WAIT_V
#undef PG8_WAIT_L
#undef PG8_BAR
#undef PG8_SCHED
}
}

typedef GAS unsigned gu32;
#define XB_TMO      128
#define XB_XCNT(j)  (256  + 64 * (j))
#define XB_XSUB(j)  (1280 + 64 * (j))
#define XB_XGEN(j)  (2304 + 64 * (j))
#define XB_TOP      3328
#define XB_TOPGEN   3392
#define XB_SPIN_CAP (1u << 20)

__device__ __forceinline__ unsigned xb_ld(unsigned* p)              { return __hip_atomic_load(p, __ATOMIC_RELAXED, __HIP_MEMORY_SCOPE_AGENT); }
__device__ __forceinline__ unsigned xb_add(unsigned* p, unsigned v) { return __hip_atomic_fetch_add(p, v, __ATOMIC_RELAXED, __HIP_MEMORY_SCOPE_AGENT); }
__device__ __forceinline__ unsigned xb_xcc_id() { return (unsigned)__builtin_amdgcn_s_getreg((3 << 11) | 20) & 0xFu; }
#define XB_SPIN(cond, bar) do { unsigned _sp = 0; while (cond) { __builtin_amdgcn_s_sleep(1); \
    if ((++_sp & 255u) == 0u) { if (xb_ld(&(bar)[XB_TMO])) break; if (_sp > XB_SPIN_CAP) { atomicAdd(&(bar)[XB_TMO], 1u); break; } } } } while (0)

#define XB_EXIT     3456
#if ONE_LAUNCH
__device__ unsigned g_barrier_words[XB_EXIT + 64];
#endif
struct XcdBarrier { unsigned* bar; unsigned x; volatile LAS unsigned* st; };
__device__ __forceinline__ XcdBarrier xcd_barrier_post(unsigned* bar, volatile LAS unsigned* st) {
    XcdBarrier b; b.bar = bar; b.x = xb_xcc_id(); b.st = st;
    if (threadIdx.x == 0) (void)xb_add(&bar[XB_XCNT(b.x)], 1u);
    return b;
}
__device__ __forceinline__ void xcd_barrier_complete(unsigned* bar, unsigned x, unsigned& nloc, unsigned& nx) {
    const unsigned G = gridDim.x * gridDim.y * gridDim.z;
    unsigned sum, cnt, mine, sp = 0u;
    for (;;) {
        sum = 0u; cnt = 0u; mine = 0u;
#pragma unroll
        for (unsigned j = 0; j < 16; ++j) { const unsigned c = xb_ld(&bar[XB_XCNT(j)]); sum += c; cnt += (c > 0u) ? 1u : 0u; mine = (j == x) ? c : mine; }
        if (sum == G) break;
        __builtin_amdgcn_s_sleep(1);
        if ((++sp & 255u) == 0u) { if (xb_ld(&bar[XB_TMO])) break; if (sp > XB_SPIN_CAP) { atomicAdd(&bar[XB_TMO], 1u); break; } }
    }
    nloc = mine > 0u ? mine : 1u; nx = cnt > 0u ? cnt : 1u;
}
__device__ __forceinline__ void xcd_barrier(const XcdBarrier& b) {
    asm volatile("s_waitcnt vmcnt(0)" ::: "memory");
    __syncthreads();
    if (threadIdx.x == 0) {
        unsigned* bar = b.bar;
        __builtin_amdgcn_s_waitcnt(0);
        unsigned nloc = b.st[0], nx = b.st[1];
        if (nloc == 0u) { xcd_barrier_complete(bar, b.x, nloc, nx); b.st[0] = nloc; b.st[1] = nx; }
        const unsigned old = xb_add(&bar[XB_XSUB(b.x)], 1u);
        const unsigned gen = old / nloc;
        if (old + 1u == (gen + 1u) * nloc) {
            __builtin_amdgcn_fence(__ATOMIC_RELEASE, "agent");
            asm volatile("s_waitcnt vmcnt(0)" ::: "memory");
            const unsigned og = xb_add(&bar[XB_TOP], 1u);
            const unsigned tg = og / nx;
            if (og + 1u == (tg + 1u) * nx) xb_add(&bar[XB_TOPGEN], 1u);
            else XB_SPIN(xb_ld(&bar[XB_TOPGEN]) == tg, bar);
            __builtin_amdgcn_fence(__ATOMIC_ACQUIRE, "agent");
            xb_add(&bar[XB_XGEN(b.x)], 1u);
            asm volatile("s_waitcnt vmcnt(0)" ::: "memory");
        } else {
            XB_SPIN(xb_ld(&bar[XB_XGEN(b.x)]) == gen, bar);
            __builtin_amdgcn_fence(__ATOMIC_ACQUIRE, "agent");
            asm volatile("s_waitcnt vmcnt(0)" ::: "memory");
        }
    }
    __syncthreads();
}

struct Frame {
    LAS unsigned char* lds;
    int tid, lane, wave, vcu, G;
    const float *x, *mem, *mem_norm, *norm_mix, *w_in, *conv_w, *w_mem_kv, *w_out, *norm_ffn, *w_router, *w_gate, *w_up, *w_down, *norm_final;
    float* out;
    bf16 *WIN, *WKV, *WOUT, *WGU, *WDN, *XB, *X1B, *H, *OP, *MIX, *MEMN, *KVM, *XG, *HID;
    float *LSE, *AFFT, *GROW, *RS0, *SS1, *RS1, *RSLOT; short* INV; int* IDX; unsigned char* X1F8;
};

__device__ __forceinline__ void tr_item(const float* W, int K, int N, bf16* WT, int mode, const float* gk, LAS float* scr, int item, int lane) {
    const int nblk = N / 32, kb = item / nblk, nb = item % nblk, k0 = 64 * kb, n0 = 32 * nb;
    const int drow0 = (mode == 0) ? n0 : ((n0 >> 7) * 256 + (n0 & 127) + (mode == 2 ? 128 : 0));
    { f32x4 w[8];
#pragma unroll
      for (int i = 0; i < 8; ++i) w[i] = __builtin_nontemporal_load((const GAS f32x4*)(W + (size_t)(k0 + 8 * i + (lane >> 3)) * N + n0 + 4 * (lane & 7)));
#pragma unroll
      for (int i = 0; i < 8; ++i) { const float gg = gk ? gk[k0 + 8 * i + (lane >> 3)] : 1.f; LAS float* d = scr + (8 * i + (lane >> 3)) * 33 + 4 * (lane & 7); d[0] = w[i].x * gg; d[1] = w[i].y * gg; d[2] = w[i].z * gg; d[3] = w[i].w * gg; } }
    LDS_WAIT(); asm volatile("" ::: "memory");
    const int c = lane & 7;
#pragma unroll
    for (int j = 0; j < 4; ++j) { const int n = (lane >> 3) + 8 * j; const LAS float* s = scr + (8 * c) * 33 + n;
        v4u o; o.x = cvtpk_s(s[0 * 33], s[1 * 33]); o.y = cvtpk_s(s[2 * 33], s[3 * 33]); o.z = cvtpk_s(s[4 * 33], s[5 * 33]); o.w = cvtpk_s(s[6 * 33], s[7 * 33]);
        __builtin_nontemporal_store(o, (GAS v4u*)(WT + (size_t)(drow0 + n) * K + k0 + 8 * c)); }
    LDS_WAIT(); asm volatile("" ::: "memory");
}
__device__ __forceinline__ void tr_item8(const float* W, int K, int N, unsigned char* WT, int mode, const float* gk, float sc, LAS float* scr, int item, int lane) {
    const int nblk = N / 32, kb = item / nblk, nb = item % nblk, k0 = 128 * kb, n0 = 32 * nb;
    const int drow0 = (mode == 0) ? n0 : ((n0 >> 7) * 256 + (n0 & 127) + (mode == 2 ? 128 : 0));
#pragma unroll
    for (int h = 0; h < 2; ++h) { f32x4 w[8];
#pragma unroll
      for (int i = 0; i < 8; ++i) w[i] = __builtin_nontemporal_load((const GAS f32x4*)(W + (size_t)(k0 + 64 * h + 8 * i + (lane >> 3)) * N + n0 + 4 * (lane & 7)));
#pragma unroll
      for (int i = 0; i < 8; ++i) { const int r = 64 * h + 8 * i + (lane >> 3); const float gg = gk ? gk[k0 + r] * sc : sc; LAS float* d = scr + r * 33 + 4 * (4 * h + (i >> 1)) + 4 * (lane & 7);
          d[0] = w[i].x * gg; d[1] = w[i].y * gg; d[2] = w[i].z * gg; d[3] = w[i].w * gg; } }
    LDS_WAIT(); asm volatile("" ::: "memory");
    const int c = lane & 7;
#pragma unroll
    for (int j = 0; j < 4; ++j) { const int n = (lane >> 3) + 8 * j; const LAS float* s = scr + (16 * c) * 33 + 4 * c + n;
        v4u o; o.x = pg8::pk4_e4m3(s[0 * 33], s[1 * 33], s[2 * 33], s[3 * 33]); o.y = pg8::pk4_e4m3(s[4 * 33], s[5 * 33], s[6 * 33], s[7 * 33]);
        o.z = pg8::pk4_e4m3(s[8 * 33], s[9 * 33], s[10 * 33], s[11 * 33]); o.w = pg8::pk4_e4m3(s[12 * 33], s[13 * 33], s[14 * 33], s[15 * 33]);
        __builtin_nontemporal_store(o, (GAS v4u*)(WT + (size_t)(drow0 + n) * K + k0 + 16 * c)); }
    LDS_WAIT(); asm volatile("" ::: "memory");
}
__device__ __forceinline__ void rms_row_to_bf16(const float* xrow, const float* g, bf16* orow, int lane) {
    const GAS f32x4* xr = (const GAS f32x4*)xrow + lane; const GAS f32x4* gr = (const GAS f32x4*)g + lane;
    f32x4 v[4]; float s = 0.f;
#pragma unroll
    for (int j = 0; j < 4; ++j) { v[j] = xr[64 * j]; s += (v[j].x * v[j].x + v[j].y * v[j].y) + (v[j].z * v[j].z + v[j].w * v[j].w); }
    const float r = 1.0f / sqrtf(wave_sum(s) * (1.f / DM) + RMS_EPS);
    GAS unsigned long long* o8 = (GAS unsigned long long*)orow + lane;
#pragma unroll
    for (int j = 0; j < 4; ++j) { const f32x4 gg = gr[64 * j]; const f32x4 o = v[j] * r * gg;
        o8[64 * j] = (unsigned long long)pk2(o.x, o.y) | ((unsigned long long)pk2(o.z, o.w) << 32); }
}
constexpr bool GU8 = true, DN8 = true;
constexpr float SC_X1 = 16.f, SC_WGU = 128.f, SC_HID = 8.f, SC_WDN = 256.f, SC_Y = 64.f;
constexpr bool Y8 = true;
constexpr int CSCR_BYTES = 17408;
constexpr int CV_IN = 16 * 80, CV_KV = 16 * 16, CV_OUT = 16 * 32, CV_SMALL = CV_IN + CV_KV + CV_OUT, CV_GU = GU8 ? 512 : 1024, CV_DN = DN8 ? 512 : 1024, CV_LE = 2 * CV_GU + CV_DN, NITEMS = 2 * CV_SMALL + 2 * NE * CV_LE;
constexpr int DEFER_PER = GU8 ? 4 : 8;
constexpr int DEFER_WG0 = 160, N_DEFER0 = (256 - DEFER_WG0) * NWAVES * DEFER_PER;
constexpr int DEFER_PER1 = GU8 ? 5 : 8;
constexpr int DEFER_WG1 = 128, N_DEFER1 = (256 - DEFER_WG1) * NWAVES * DEFER_PER1;
constexpr int ATT_TAIL = GU8 ? 2 : 3, N_ATTT = 128 * NWAVES * ATT_TAIL;
constexpr int N_DEFER = N_DEFER0 + N_DEFER1 + 2 * N_ATTT;
__device__ __forceinline__ void conv_item(Frame& F, int it, LAS float* scr) {
    if (it < 2 * CV_SMALL) {
        const int l = it / CV_SMALL; int r = it % CV_SMALL;
        if (r < CV_IN) { tr_item(F.w_in + (size_t)l * DM * INW, DM, INW, F.WIN + (size_t)l * INW * DM, 0, F.norm_mix + (size_t)l * DM, scr, r, F.lane); return; } r -= CV_IN;
        if (r < CV_KV) { tr_item(F.w_mem_kv + (size_t)l * DM * 512, DM, 512, F.WKV + (size_t)l * 512 * DM, 0, nullptr, scr, r, F.lane); return; } r -= CV_KV;
        tr_item(F.w_out + (size_t)l * DM * DM, DM, DM, F.WOUT + (size_t)l * DM * DM, 0, nullptr, scr, r, F.lane);
    } else {
        const int r = it - 2 * CV_SMALL; const int le = r / CV_LE, q = r % CV_LE;
        if (q < 2 * CV_GU) { const int up = q >= CV_GU, item = q - up * CV_GU; const float* W = (up ? F.w_up : F.w_gate) + (size_t)le * DM * FF; const float* gk = F.norm_ffn + (size_t)(le / NE) * DM;
            if (GU8) tr_item8(W, DM, FF, (unsigned char*)F.WGU + (size_t)le * 2 * FF * DM, 1 + up, gk, SC_WGU, scr, item, F.lane);
            else tr_item(W, DM, FF, F.WGU + (size_t)le * 2 * FF * DM, 1 + up, gk, scr, item, F.lane); }
        else { const int item = q - 2 * CV_GU;
            if (DN8) tr_item8(F.w_down + (size_t)le * FF * DM, FF, DM, (unsigned char*)F.WDN + (size_t)le * DM * FF, 0, nullptr, SC_WDN, scr, item, F.lane);
            else tr_item(F.w_down + (size_t)le * FF * DM, FF, DM, F.WDN + (size_t)le * DM * FF, 0, nullptr, scr, item, F.lane); }
    }
}
__device__ __forceinline__ void p0_prologue(Frame& F) {
    LAS float* scr = (LAS float*)(F.lds + F.wave * CSCR_BYTES);
    const int gw = F.vcu * NWAVES + F.wave, NGW = F.G * NWAVES;
    for (int it = gw; it < NITEMS - N_DEFER; it += NGW) conv_item(F, it, scr);
    for (int m = gw; m < NB * MEMT; m += NGW) rms_row_to_bf16(F.mem + (size_t)m * DM, F.mem_norm, F.MEMN + (size_t)m * DM, F.lane);
    for (int m = gw; m < T; m += NGW) {
        const GAS f32x4* xr = (const GAS f32x4*)(F.x + (size_t)m * DM) + F.lane; f32x4 v[4]; float ss = 0.f;
#pragma unroll
        for (int j = 0; j < 4; ++j) { v[j] = __builtin_nontemporal_load(xr + 64 * j); ss += (v[j].x * v[j].x + v[j].y * v[j].y) + (v[j].z * v[j].z + v[j].w * v[j].w); }
        GAS unsigned long long* o8 = (GAS unsigned long long*)(F.XB + (size_t)m * DM) + F.lane;
#pragma unroll
        for (int j = 0; j < 4; ++j) o8[64 * j] = (unsigned long long)pk2(v[j].x, v[j].y) | ((unsigned long long)pk2(v[j].z, v[j].w) << 32);
        const float r = 1.0f / sqrtf(wave_sum(ss) * (1.f / DM) + RMS_EPS);
        if (F.lane == 0) F.RS0[m] = r;
    }
}

__device__ __forceinline__ s16x4 vtr(LAS unsigned char* p) { typedef short v4i16_t __attribute__((ext_vector_type(4))); return __builtin_bit_cast(s16x4, __builtin_amdgcn_ds_read_tr16_b64_v4i16((LAS v4i16_t*)p)); }
constexpr int KROW = 144;
constexpr int VROW = 192;
template <bool DIL>
__device__ __forceinline__ void attn_item(const bf16* qp, long q_rs, const bf16* kp, const bf16* vp, long kv_rs, int t_lo, int t_hi, int nt_total, float c2,
                                          bf16* op, long o_rs, float* lsep, long lse_rs, LAS unsigned char* kbuf, LAS unsigned char* vbuf, int lane) {
    const int ql = lane & 31, hh = lane >> 5;
    bf16x8 qf[4];
#pragma unroll
    for (int s = 0; s < 4; ++s) qf[s] = *(const GAS bf16x8*)(qp + (long)ql * q_rs + 16 * s + 8 * hh);
    f32x16 o0, o1;
#pragma unroll
    for (int i = 0; i < 16; ++i) { o0[i] = 0.f; o1[i] = 0.f; }
    float m_run = -INFINITY, l_run = 0.f;
    const float c1 = 0.125f * LOG2E;
    const float relbase = (float)(4 * hh - ql - 64);
    const int vq = (lane & 15) >> 2;
    LAS unsigned char* vrd = vbuf + (4 * hh + vq) * VROW + ((lane >> 4) & 1) * 32 + 8 * (lane & 3);
    LAS unsigned char* vwr = vbuf + (lane >> 3) * VROW + (lane & 7) * 16;
    LAS unsigned char* kwr = kbuf + (lane >> 3) * KROW + (lane & 7) * 16;
    LAS unsigned char* krd = kbuf + ql * KROW + 16 * hh;
    const bf16* krow = kp + (long)(32 * t_lo + (lane >> 3)) * kv_rs + 8 * (lane & 7);
    const bf16* vrow = vp + (long)(32 * t_lo + (lane >> 3)) * kv_rs + 8 * (lane & 7);
    v4u kk[4], vv[4];
#pragma unroll
    for (int i4 = 0; i4 < 4; ++i4) kk[i4] = *(const GAS v4u*)(krow + (long)(8 * i4) * kv_rs);
#pragma unroll
    for (int i4 = 0; i4 < 4; ++i4) vv[i4] = *(const GAS v4u*)(vrow + (long)(8 * i4) * kv_rs);
#pragma unroll 1
    for (int TI = t_lo; TI < t_hi; ++TI) {
        krow += 32 * kv_rs; vrow += 32 * kv_rs;
#pragma unroll
        for (int i4 = 0; i4 < 4; ++i4) *(LAS v4u*)(kwr + 8 * i4 * KROW) = kk[i4];
#pragma unroll
        for (int i4 = 0; i4 < 4; ++i4) *(LAS v4u*)(vwr + 8 * i4 * VROW) = vv[i4];
        if (TI + 1 < t_hi) {
#pragma unroll
            for (int i4 = 0; i4 < 4; ++i4) kk[i4] = *(const GAS v4u*)(krow + (long)(8 * i4) * kv_rs);
#pragma unroll
            for (int i4 = 0; i4 < 4; ++i4) vv[i4] = *(const GAS v4u*)(vrow + (long)(8 * i4) * kv_rs);
        }
        bf16x8 kf[4];
#pragma unroll
        for (int ss = 0; ss < 4; ++ss) kf[ss] = *(const LAS bf16x8*)(krd + 32 * ss);
        f32x16 acc;
#pragma unroll
        for (int i = 0; i < 16; ++i) acc[i] = 0.f;
#pragma unroll
        for (int ss = 0; ss < 4; ++ss) acc = __builtin_amdgcn_mfma_f32_32x32x16_bf16(kf[ss], qf[ss], acc, 0, 0, 0);
        if (DIL) {
            const float rb = relbase + (float)(32 * TI);
            const bool edge = (TI == 0) || (TI == nt_total - 1);
#pragma unroll
            for (int i = 0; i < 16; ++i) { const float ar = __builtin_fabsf(rb + (float)((i & 3) + 8 * (i >> 2))); float v = acc[i] * c1 - c2 * ar; if (edge) v = (ar > 64.f) ? -INFINITY : v; acc[i] = v; }
        } else {
#pragma unroll
            for (int i = 0; i < 16; ++i) acc[i] *= c1;
        }
        float mx = acc[0];
#pragma unroll
        for (int i = 1; i < 16; ++i) mx = __builtin_fmaxf(mx, acc[i]);
        mx = __builtin_fmaxf(mx, __shfl_xor(mx, 32));
        const float m_new = __builtin_fmaxf(m_run, mx);
        const float alpha = __builtin_amdgcn_exp2f(m_run - m_new);
        m_run = m_new;
        float ps = 0.f;
#pragma unroll
        for (int i = 0; i < 16; ++i) { acc[i] = __builtin_amdgcn_exp2f(acc[i] - m_new); ps += acc[i]; }
        l_run = l_run * alpha + ps;
#pragma unroll
        for (int i = 0; i < 16; ++i) { o0[i] *= alpha; o1[i] *= alpha; }
#pragma unroll
        for (int sk = 0; sk < 2; ++sk) {
            v4u pw; pw.x = cvtpk_s(acc[8 * sk + 0], acc[8 * sk + 1]); pw.y = cvtpk_s(acc[8 * sk + 2], acc[8 * sk + 3]);
            pw.z = cvtpk_s(acc[8 * sk + 4], acc[8 * sk + 5]); pw.w = cvtpk_s(acc[8 * sk + 6], acc[8 * sk + 7]);
            const bf16x8 pf = __builtin_bit_cast(bf16x8, pw);
            const s16x4 a0 = vtr(vrd + (16 * sk) * VROW), a1 = vtr(vrd + (16 * sk + 8) * VROW);
            const s16x4 b0 = vtr(vrd + (16 * sk) * VROW + 64), b1 = vtr(vrd + (16 * sk + 8) * VROW + 64);
            const bf16x8 vf0 = (bf16x8){a0[0], a0[1], a0[2], a0[3], a1[0], a1[1], a1[2], a1[3]};
            const bf16x8 vf1 = (bf16x8){b0[0], b0[1], b0[2], b0[3], b1[0], b1[1], b1[2], b1[3]};
            o0 = __builtin_amdgcn_mfma_f32_32x32x16_bf16(vf0, pf, o0, 0, 0, 0);
            o1 = __builtin_amdgcn_mfma_f32_32x32x16_bf16(vf1, pf, o1, 0, 0, 0);
        }
    }
    const float l_tot = l_run + __shfl_xor(l_run, 32);
    const float inv = 1.0f / l_tot;
    LAS unsigned char* ost = kbuf + ql * KROW + 8 * hh;
#pragma unroll
    for (int g4 = 0; g4 < 4; ++g4) {
        v2u w0, w1;
        w0.x = cvtpk_s(o0[4 * g4 + 0] * inv, o0[4 * g4 + 1] * inv); w0.y = cvtpk_s(o0[4 * g4 + 2] * inv, o0[4 * g4 + 3] * inv);
        w1.x = cvtpk_s(o1[4 * g4 + 0] * inv, o1[4 * g4 + 1] * inv); w1.y = cvtpk_s(o1[4 * g4 + 2] * inv, o1[4 * g4 + 3] * inv);
        *(LAS v2u*)(ost + 16 * g4) = w0; *(LAS v2u*)(ost + 64 + 16 * g4) = w1;
    }
    if (lsep != nullptr && hh == 0) lsep[(long)ql * lse_rs] = m_run + __builtin_log2f(l_tot);
#pragma unroll
    for (int i4 = 0; i4 < 4; ++i4) { const int row = (lane >> 3) + 8 * i4; const v4u w = *(const LAS v4u*)(kbuf + row * KROW + (lane & 7) * 16);
        *(GAS v4u*)(op + (long)row * o_rs + 8 * (lane & 7)) = w; }
}
__device__ __forceinline__ void p_attn_fast(Frame& F, int l) {
    LAS unsigned char* vbuf = F.lds + F.wave * 19200; LAS unsigned char* kbuf = vbuf + 6144;
    const int b = blockIdx.x % 8, widx = (blockIdx.x / 8) * NWAVES + F.wave, nw = (F.G / 8) * NWAVES;
    constexpr int NMEM = NMH * 64, NDIL = NDH * 3 * 64;
    for (int it = widx; it < NMEM + NDIL; it += nw) {
        if (it < NMEM) {
            const int hm = it / 64, blk = it % 64; const long row0 = (long)b * SEQ + 32 * blk;
            const bf16* kp = F.KVM + (size_t)(b * MEMT) * 1024 + 512 * l + 64 * hm;
            attn_item<false>(F.H + row0 * INW + C_QM + 64 * hm, INW, kp, kp + 256, 1024, 0, 8, 8, 0.f,
                                   F.MIX + row0 * DM + 768 + 64 * hm, DM, nullptr, 0, kbuf, vbuf, F.lane);
        } else {
            const int j = it - NMEM, h = j / 192, p = (j % 192) / 64, blk = j % 64;
            const int d = (p == 0) ? 1 : (p == 1 ? 4 : 16), L = SEQ / d, nb = L / 32, r = blk / nb, n = blk % nb;
            const long rowq = (long)b * SEQ + (long)(32 * n) * d + r, rowk = (long)b * SEQ + (long)(32 * n - 64) * d + r;
            const int t_lo = (n >= 2) ? 0 : 2 - n, t_hi = (n + 3 <= nb) ? 5 : nb + 2 - n;
            const float slope = __builtin_exp2f(-8.0f * (float)(h + 1) / (float)NDH);
            attn_item<true>(F.H + rowq * INW + C_Q + 64 * h, (long)d * INW, F.H + rowk * INW + C_K + 64 * h, F.H + rowk * INW + C_V + 64 * h, (long)d * INW, t_lo, t_hi, 5, slope * (float)d * LOG2E,
                                  F.OP + ((size_t)p * T + rowq) * 384 + 64 * h, (long)d * 384, F.LSE + ((size_t)p * T + rowq) * 6 + h, (long)d * 6, kbuf, vbuf, F.lane);
        }
    }
    if (widx >= 128 && SK(1)) {
        LAS float* cscr = (LAS float*)vbuf;
        const int first = NITEMS - N_DEFER + l * N_ATTT, w0 = b * 128 + (widx - 128);
        for (int j = 0; j < ATT_TAIL; ++j) conv_item(F, first + w0 + j * 1024, cscr);
    }
}

__device__ __forceinline__ void p_merge_conv(Frame& F, int l) {
    const int gw = F.vcu * NWAVES + F.wave, NGW = F.G * NWAVES;
    const float* cw = F.conv_w + (size_t)l * 3 * CONVC;
    for (int row = gw; row < T; row += NGW) {
        const int t = row % SEQ;
        if (F.lane < 48) {
            const int c0 = F.lane * 8;
            const bf16* hr = F.H + (size_t)row * INW;
            const v4u z = (v4u){0u, 0u, 0u, 0u};
            const v4u xm = (t > 0) ? *(const GAS v4u*)(hr - INW + C_XC + c0) : z, cm = (t > 0) ? *(const GAS v4u*)(hr - INW + C_CG + c0) : z;
            const v4u x0 = *(const GAS v4u*)(hr + C_XC + c0), cc = *(const GAS v4u*)(hr + C_CG + c0), bg = *(const GAS v4u*)(hr + C_BG + c0);
            const v4u xp = (t < SEQ - 1) ? *(const GAS v4u*)(hr + INW + C_XC + c0) : z, cp = (t < SEQ - 1) ? *(const GAS v4u*)(hr + INW + C_CG + c0) : z;
            float w0[8], w1[8], w2[8];
#pragma unroll
            for (int i = 0; i < 8; ++i) { w0[i] = cw[c0 + i]; w1[i] = cw[CONVC + c0 + i]; w2[i] = cw[2 * CONVC + c0 + i]; }
            v4u o;
#pragma unroll
            for (int i = 0; i < 4; ++i) {
                const float ulo = w0[2 * i] * (bflo(cm[i]) * bflo(xm[i])) + w1[2 * i] * (bflo(cc[i]) * bflo(x0[i])) + w2[2 * i] * (bflo(cp[i]) * bflo(xp[i]));
                const float uhi = w0[2 * i + 1] * (bfhi(cm[i]) * bfhi(xm[i])) + w1[2 * i + 1] * (bfhi(cc[i]) * bfhi(x0[i])) + w2[2 * i + 1] * (bfhi(cp[i]) * bfhi(xp[i]));
                o[i] = pk2(bflo(bg[i]) * ulo, bfhi(bg[i]) * uhi);
            }
            *(GAS v4u*)(F.MIX + (size_t)row * DM + c0) = o;
            const int h = F.lane >> 3;
            const float l0 = F.LSE[((size_t)0 * T + row) * 6 + h], l1 = F.LSE[((size_t)1 * T + row) * 6 + h], l2 = F.LSE[((size_t)2 * T + row) * 6 + h];
            const float mx = __builtin_fmaxf(l0, __builtin_fmaxf(l1, l2));
            float e0 = __builtin_amdgcn_exp2f(l0 - mx), e1 = __builtin_amdgcn_exp2f(l1 - mx), e2 = __builtin_amdgcn_exp2f(l2 - mx);
            const float inv = 1.0f / (e0 + e1 + e2); e0 *= inv; e1 *= inv; e2 *= inv;
            const v4u a0 = *(const GAS v4u*)(F.OP + ((size_t)0 * T + row) * 384 + c0), a1 = *(const GAS v4u*)(F.OP + ((size_t)1 * T + row) * 384 + c0), a2 = *(const GAS v4u*)(F.OP + ((size_t)2 * T + row) * 384 + c0);
            v4u od;
#pragma unroll
            for (int i = 0; i < 4; ++i) od[i] = pk2(e0 * bflo(a0[i]) + e1 * bflo(a1[i]) + e2 * bflo(a2[i]), e0 * bfhi(a0[i]) + e1 * bfhi(a1[i]) + e2 * bfhi(a2[i]));
            *(GAS v4u*)(F.MIX + (size_t)row * DM + 384 + c0) = od;
        }
    }
}

__device__ __forceinline__ void p_norm_router(Frame& F, int l) {
    LAS float* wl = (LAS float*)F.lds;
    const float* wr = F.w_router + (size_t)l * DM * NE;
    const float* g = F.norm_ffn + (size_t)l * DM;
    { f32x4 wv[8]; float gv[8];
#pragma unroll
      for (int k = 0; k < 8; ++k) { const int i4 = F.tid + 512 * k; wv[k] = *(const GAS f32x4*)(wr + 4 * i4); gv[k] = g[i4 >> 2]; }
#pragma unroll
      for (int k = 0; k < 8; ++k) { const int i4 = F.tid + 512 * k, d = i4 >> 2, e0 = (i4 & 3) * 4;
          wl[(e0 + 0) * DM + d] = wv[k].x * gv[k]; wl[(e0 + 1) * DM + d] = wv[k].y * gv[k]; wl[(e0 + 2) * DM + d] = wv[k].z * gv[k]; wl[(e0 + 3) * DM + d] = wv[k].w * gv[k]; } }
    __syncthreads();
    const int gw = F.vcu * NWAVES + F.wave, NGW = F.G * NWAVES;
    const bool b5 = (F.lane & 32) != 0, b4 = (F.lane & 16) != 0, b3 = (F.lane & 8) != 0, b2 = (F.lane & 4) != 0, b1 = (F.lane & 2) != 0;
    v2u vn[2][4];
    if (gw < T / 2) {
#pragma unroll
        for (int r = 0; r < 2; ++r) { const GAS v2u* xr = (const GAS v2u*)(F.X1B + (size_t)(2 * gw + r) * DM) + F.lane;
#pragma unroll
            for (int j = 0; j < 4; ++j) vn[r][j] = xr[64 * j]; }
    }
    for (int pr = gw; pr < T / 2; pr += NGW) {
        const int row0 = 2 * pr;
        f32x4 v[2][4];
#pragma unroll
        for (int r = 0; r < 2; ++r)
#pragma unroll
            for (int j = 0; j < 4; ++j) { v[r][j].x = bflo(vn[r][j].x); v[r][j].y = bfhi(vn[r][j].x); v[r][j].z = bflo(vn[r][j].y); v[r][j].w = bfhi(vn[r][j].y); }
        float ssum[2];
#pragma unroll
        for (int r = 0; r < 2; ++r) { const GAS f32x4* sp = (const GAS f32x4*)(F.SS1 + (size_t)(row0 + r) * 16); const f32x4 p0 = sp[0], p1 = sp[1], p2 = sp[2], p3 = sp[3];
            ssum[r] = ((((p0.x + p0.y) + (p0.z + p0.w)) + ((p1.x + p1.y) + (p1.z + p1.w))) + (((p2.x + p2.y) + (p2.z + p2.w)) + ((p3.x + p3.y) + (p3.z + p3.w)))); }
        const float r0 = 1.0f / sqrtf(ssum[0] * (1.f / DM) + RMS_EPS), r1 = 1.0f / sqrtf(ssum[1] * (1.f / DM) + RMS_EPS);
        if (pr + NGW < T / 2) {
#pragma unroll
            for (int r = 0; r < 2; ++r) { const GAS v2u* xr = (const GAS v2u*)(F.X1B + (size_t)(2 * (pr + NGW) + r) * DM) + F.lane;
#pragma unroll
                for (int j = 0; j < 4; ++j) vn[r][j] = xr[64 * j]; }
        }
        float lg[32];
        LAS float* wlp = wl + 4 * F.lane; asm volatile("" : "+v"(wlp));
#pragma unroll
        for (int e = 0; e < NE; ++e) { float a0 = 0.f, a1 = 0.f;
#pragma unroll
            for (int j = 0; j < 4; ++j) { const f32x4 w = *(const LAS f32x4*)(wlp + e * DM + 256 * j);
                a0 = __builtin_fmaf(v[0][j].x, w.x, a0); a0 = __builtin_fmaf(v[0][j].y, w.y, a0); a0 = __builtin_fmaf(v[0][j].z, w.z, a0); a0 = __builtin_fmaf(v[0][j].w, w.w, a0);
                a1 = __builtin_fmaf(v[1][j].x, w.x, a1); a1 = __builtin_fmaf(v[1][j].y, w.y, a1); a1 = __builtin_fmaf(v[1][j].z, w.z, a1); a1 = __builtin_fmaf(v[1][j].w, w.w, a1); }
            asm volatile("" : "+v"(wlp), "+v"(a0), "+v"(a1)); lg[e] = a0; lg[16 + e] = a1; }
        if (F.lane == 0) { F.RS1[row0] = r0; F.RS1[row0 + 1] = r1; }
#pragma unroll
        for (int k = 0; k < 16; ++k) { const float keep = b5 ? lg[16 + k] : lg[k], send = b5 ? lg[k] : lg[16 + k]; lg[k] = keep + __shfl_xor(send, 32); }
#pragma unroll
        for (int k = 0; k < 8; ++k) { const float keep = b4 ? lg[8 + k] : lg[k], send = b4 ? lg[k] : lg[8 + k]; lg[k] = keep + __shfl_xor(send, 16); }
#pragma unroll
        for (int k = 0; k < 4; ++k) { const float keep = b3 ? lg[4 + k] : lg[k], send = b3 ? lg[k] : lg[4 + k]; lg[k] = keep + __shfl_xor(send, 8); }
#pragma unroll
        for (int k = 0; k < 2; ++k) { const float keep = b2 ? lg[2 + k] : lg[k], send = b2 ? lg[k] : lg[2 + k]; lg[k] = keep + __shfl_xor(send, 4); }
        { const float keep = b1 ? lg[1] : lg[0], send = b1 ? lg[0] : lg[1]; lg[0] = keep + __shfl_xor(send, 2); }
        float lgt = (lg[0] + __shfl_xor(lg[0], 1)) * (b5 ? r1 : r0);
        float mx = lgt;
#pragma unroll
        for (int m = 2; m <= 16; m <<= 1) mx = __builtin_fmaxf(mx, __shfl_xor(mx, m));
        const float ex = __expf(lgt - mx); float sum = ex;
#pragma unroll
        for (int m = 2; m <= 16; m <<= 1) sum += __shfl_xor(sum, m);
        const int e = (b4 ? 8 : 0) + (b3 ? 4 : 0) + (b2 ? 2 : 0) + (b1 ? 1 : 0);
        const int row = row0 + (b5 ? 1 : 0), bb = row / SEQ, t = row % SEQ;
        if ((F.lane & 1) == 0) F.AFFT[((size_t)bb * NE + e) * SEQ + t] = ex / sum;
    }
    __syncthreads();
}

constexpr int RW_RS = 2064;
__device__ __forceinline__ void p_router_mfma(Frame& F, int l) {
    LAS unsigned char* WH = F.lds; LAS unsigned char* WL = F.lds + 16 * RW_RS; LAS f32x4* XCH = (LAS f32x4*)(F.lds + 32 * RW_RS);
    const float* wr = F.w_router + (size_t)l * DM * NE;
    const float* g = F.norm_ffn + (size_t)l * DM;
    { f32x4 wa[4], wb[4]; float ga[4], gb[4];
#pragma unroll
      for (int k = 0; k < 4; ++k) { const int c = F.tid + 512 * k, dp = c >> 2, e0 = (c & 3) * 4;
          wa[k] = *(const GAS f32x4*)(wr + (size_t)(2 * dp) * NE + e0); wb[k] = *(const GAS f32x4*)(wr + (size_t)(2 * dp + 1) * NE + e0); ga[k] = g[2 * dp]; gb[k] = g[2 * dp + 1]; }
#pragma unroll
      for (int k = 0; k < 4; ++k) { const int c = F.tid + 512 * k, dp = c >> 2, e0 = (c & 3) * 4;
#pragma unroll
          for (int j = 0; j < 4; ++j) { const float va = wa[k][j] * ga[k], vb = wb[k][j] * gb[k];
              const unsigned ha = f2bf(va), hb = f2bf(vb);
              const float ra = va - __builtin_bit_cast(float, ha << 16), rb = vb - __builtin_bit_cast(float, hb << 16);
              *(LAS unsigned*)(WH + (e0 + j) * RW_RS + 4 * dp) = ha | (hb << 16);
              *(LAS unsigned*)(WL + (e0 + j) * RW_RS + 4 * dp) = f2bf(ra) | (f2bf(rb) << 16); } } }
    __syncthreads();
    int tid_ = F.tid; asm volatile("" : "+v"(tid_));
    const int lane = tid_ & 63, tile = F.wave >> 1, kh = F.wave & 1, r16 = lane & 15, kq = lane >> 4;
    for (int blk = F.vcu; blk < T / 64; blk += F.G) {
        const int row0 = blk * 64 + tile * 16;
        const bf16* xr = F.X1B + (size_t)(row0 + r16) * DM + 512 * kh + 8 * kq;
        bf16x8 af[16];
#pragma unroll
        for (int s_ = 0; s_ < 16; ++s_) af[s_] = *(const GAS bf16x8*)(xr + 32 * s_);
        float rsum; { const f32x4 pp = *(const GAS f32x4*)(F.SS1 + (size_t)(row0 + (lane >> 2)) * 16 + 4 * (lane & 3)); rsum = (pp.x + pp.y) + (pp.z + pp.w); }
        rsum += __shfl_xor(rsum, 1); rsum += __shfl_xor(rsum, 2);
        const float rrow = 1.0f / sqrtf(rsum * (1.f / DM) + RMS_EPS);
        f32x4 acc = (f32x4){0.f, 0.f, 0.f, 0.f};
        const LAS unsigned char* bh = WH + r16 * RW_RS + (512 * kh + 8 * kq) * 2; const LAS unsigned char* bl = WL + r16 * RW_RS + (512 * kh + 8 * kq) * 2;
#pragma unroll
        for (int s_ = 0; s_ < 16; ++s_) {
            const bf16x8 fh = *(const LAS bf16x8*)(bh + 64 * s_), fl = *(const LAS bf16x8*)(bl + 64 * s_);
            acc = __builtin_amdgcn_mfma_f32_16x16x32_bf16(af[s_], fh, acc, 0, 0, 0);
            acc = __builtin_amdgcn_mfma_f32_16x16x32_bf16(af[s_], fl, acc, 0, 0, 0);
        }
        if (kh == 1) XCH[tile * 64 + lane] = acc;
        __syncthreads();
        if (kh == 0) {
            acc = acc + XCH[tile * 64 + lane];
            float rs4[4];
#pragma unroll
            for (int j = 0; j < 4; ++j) rs4[j] = __shfl(rrow, 4 * (4 * kq + j));
            f32x4 aff;
#pragma unroll
            for (int j = 0; j < 4; ++j) {
                const float lg = acc[j] * rs4[j];
                float mx = lg;
#pragma unroll
                for (int m = 1; m <= 8; m <<= 1) mx = __builtin_fmaxf(mx, __shfl_xor(mx, m));
                const float ex = __expf(lg - mx); float sm = ex;
#pragma unroll
                for (int m = 1; m <= 8; m <<= 1) sm += __shfl_xor(sm, m);
                aff[j] = ex / sm;
            }
            const int rowa = row0 + 4 * kq, bb = rowa / SEQ, t = rowa % SEQ;
            *(GAS f32x4*)(F.AFFT + ((size_t)bb * NE + r16) * SEQ + t) = aff;
            if (r16 == 0) *(GAS f32x4*)(F.RS1 + rowa) = (f32x4){rs4[0], rs4[1], rs4[2], rs4[3]};
        }
        __syncthreads();
    }
}

__device__ __forceinline__ void p_topk_pair(Frame& F, int b, int e, LAS int* lidx, LAS float* lrs, bool writer) {
    LAS unsigned* cnt = (LAS unsigned*)F.lds;
    LAS unsigned* tab = (LAS unsigned*)(F.lds + 256);
    {
        const float* src = F.AFFT + (size_t)(b * NE + e) * SEQ;
        unsigned x[4];
#pragma unroll
        for (int i = 0; i < 4; ++i) x[i] = __builtin_bit_cast(unsigned, src[i * 512 + F.tid]);
        float rs1v[4];
#pragma unroll
        for (int i = 0; i < 4; ++i) rs1v[i] = F.RS1[(size_t)b * SEQ + i * 512 + F.tid];
        unsigned prefix = 0u;
#pragma unroll 1
        for (int ps = 0; ps < 16; ++ps) {
            const int sh = 30 - 2 * ps;
            const unsigned c1 = prefix | (1u << sh), c2 = prefix | (2u << sh), c3 = prefix | (3u << sh);
            unsigned n1 = 0u, n2 = 0u, n3 = 0u;
#pragma unroll
            for (int i = 0; i < 4; ++i) { n1 += (unsigned)__builtin_popcountll(__ballot(x[i] >= c1)); n2 += (unsigned)__builtin_popcountll(__ballot(x[i] >= c2)); n3 += (unsigned)__builtin_popcountll(__ballot(x[i] >= c3)); }
            const int par = (ps & 1) * 24;
            if (F.lane == 0) { cnt[par + F.wave] = n1; cnt[par + 8 + F.wave] = n2; cnt[par + 16 + F.wave] = n3; }
            __syncthreads();
            unsigned t1 = 0u, t2 = 0u, t3 = 0u;
#pragma unroll
            for (int w = 0; w < 8; ++w) { t1 += cnt[par + w]; t2 += cnt[par + 8 + w]; t3 += cnt[par + 16 + w]; }
            if (t3 >= (unsigned)CAP) prefix = c3; else if (t2 >= (unsigned)CAP) prefix = c2; else if (t1 >= (unsigned)CAP) prefix = c1;
        }
        unsigned long long bq[4], bs[4];
#pragma unroll
        for (int i = 0; i < 4; ++i) { const unsigned long long bg = __ballot(x[i] > prefix); bq[i] = __ballot(x[i] == prefix);
            if (F.lane == 0) { tab[i * 8 + F.wave] = (unsigned)__builtin_popcountll(bg); tab[32 + i * 8 + F.wave] = (unsigned)__builtin_popcountll(bq[i]); } }
        __syncthreads();
        unsigned gtot = 0u;
#pragma unroll
        for (int j = 0; j < 32; ++j) gtot += tab[j];
        const unsigned need = (unsigned)CAP - gtot;
        unsigned run = 0u, eqb[4];
#pragma unroll
        for (int j = 0; j < 32; ++j) { const unsigned v = tab[32 + j];
#pragma unroll
            for (int i = 0; i < 4; ++i) if (j == i * 8 + F.wave) eqb[i] = run;
            run += v; }
        bool sel[4];
#pragma unroll
        for (int i = 0; i < 4; ++i) {
            const unsigned rk = eqb[i] + __builtin_amdgcn_mbcnt_hi((unsigned)(bq[i] >> 32), __builtin_amdgcn_mbcnt_lo((unsigned)bq[i], 0u));
            sel[i] = (x[i] > prefix) || (x[i] == prefix && rk < need);
            bs[i] = __ballot(sel[i]);
            if (F.lane == 0) tab[64 + i * 8 + F.wave] = (unsigned)__builtin_popcountll(bs[i]);
        }
        __syncthreads();
        run = 0u; unsigned selb[4];
#pragma unroll
        for (int j = 0; j < 32; ++j) { const unsigned v = tab[64 + j];
#pragma unroll
            for (int i = 0; i < 4; ++i) if (j == i * 8 + F.wave) selb[i] = run;
            run += v; }
#pragma unroll
        for (int i = 0; i < 4; ++i) {
            const int t = i * 512 + F.tid, row = b * SEQ + t;
            const unsigned slot = selb[i] + __builtin_amdgcn_mbcnt_hi((unsigned)(bs[i] >> 32), __builtin_amdgcn_mbcnt_lo((unsigned)bs[i], 0u));
            if (sel[i]) { lidx[slot] = row; lrs[slot] = rs1v[i] * (GU8 ? 1.f / (SC_X1 * SC_WGU) : 1.f); if (writer) F.GROW[(size_t)e * ER + b * CAP + slot] = __builtin_bit_cast(float, x[i]) * ((DN8 ? 1.f / (SC_HID * SC_WDN) : 1.f) * (Y8 ? SC_Y : 1.f)); }
            if (writer) F.INV[(size_t)row * NE + e] = (short)(sel[i] ? (int)slot : -1);
        }
        __syncthreads();
    }
}

template <bool YF8>
__device__ __forceinline__ void p_combine_norm(Frame& F, int l) {
    const int gw = F.vcu * NWAVES + F.wave, NGW = F.G * NWAVES;
    const bf16* Y = F.XG;
    const GAS f32x4* gr = (const GAS f32x4*)F.norm_final + F.lane;
    for (int pr = gw; pr < T / 2; pr += NGW) {
        typedef float f32x2 __attribute__((ext_vector_type(2)));
        v2u xv[2][4]; typename std::conditional<YF8, unsigned, v2u>::type yv[2][4][4]; float ysc[2][4]; unsigned rest[2]; int invr[2];
#pragma unroll
        for (int q = 0; q < 2; ++q) {
            const int row = pr + q * (T / 2), b = row / SEQ;
            const GAS v2u* xr = (const GAS v2u*)(F.X1B + (size_t)row * DM) + F.lane;
#pragma unroll
            for (int j = 0; j < 4; ++j) xv[q][j] = xr[64 * j];
            invr[q] = (int)F.INV[(size_t)row * NE + (F.lane & 15)];
            unsigned m = (unsigned)__ballot(invr[q] >= 0) & 0xffffu;
#pragma unroll
            for (int k = 0; k < 4; ++k) {
                const bool has = m != 0u; const int e = has ? __builtin_ctz(m) : 0; m &= m - 1u;
                const int r = has ? __builtin_amdgcn_readlane(invr[q], e) : 0;
                ysc[q][k] = has ? (YF8 ? 1.f / SC_Y : 1.f) : 0.f;
                if constexpr (YF8) { const GAS unsigned* yr = (const GAS unsigned*)((const unsigned char*)Y + ((size_t)e * ER + b * CAP + r) * DM) + F.lane;
#pragma unroll
                    for (int j = 0; j < 4; ++j) yv[q][k][j] = yr[64 * j]; }
                else { const GAS v2u* yr = (const GAS v2u*)(Y + ((size_t)e * ER + b * CAP + r) * DM) + F.lane;
#pragma unroll
                    for (int j = 0; j < 4; ++j) yv[q][k][j] = yr[64 * j]; }
            }
            rest[q] = m;
        }
#pragma unroll
        for (int q = 0; q < 2; ++q) {
            const int row = pr + q * (T / 2), b = row / SEQ;
            f32x4 v[4];
#pragma unroll
            for (int j = 0; j < 4; ++j) { v[j].x = bflo(xv[q][j].x); v[j].y = bfhi(xv[q][j].x); v[j].z = bflo(xv[q][j].y); v[j].w = bfhi(xv[q][j].y); }
#pragma unroll
            for (int k = 0; k < 4; ++k)
#pragma unroll
                for (int j = 0; j < 4; ++j) { const float sc = ysc[q][k];
                    if constexpr (YF8) { const unsigned w = yv[q][k][j]; const f32x2 lo = __builtin_amdgcn_cvt_pk_f32_fp8((int)w, false), hi = __builtin_amdgcn_cvt_pk_f32_fp8((int)w, true);
                        v[j].x += sc * lo.x; v[j].y += sc * lo.y; v[j].z += sc * hi.x; v[j].w += sc * hi.y; }
                    else { const v2u w = yv[q][k][j]; v[j].x += sc * bflo(w.x); v[j].y += sc * bfhi(w.x); v[j].z += sc * bflo(w.y); v[j].w += sc * bfhi(w.y); } }
            unsigned m = rest[q];
            while (m != 0u) {
                const int e = __builtin_ctz(m); m &= m - 1u; const int r = __builtin_amdgcn_readlane(invr[q], e);
                if constexpr (YF8) { const GAS unsigned* yr = (const GAS unsigned*)((const unsigned char*)Y + ((size_t)e * ER + b * CAP + r) * DM) + F.lane;
#pragma unroll
                    for (int j = 0; j < 4; ++j) { const unsigned w = yr[64 * j]; const f32x2 lo = __builtin_amdgcn_cvt_pk_f32_fp8((int)w, false), hi = __builtin_amdgcn_cvt_pk_f32_fp8((int)w, true);
                        v[j].x += (1.f / SC_Y) * lo.x; v[j].y += (1.f / SC_Y) * lo.y; v[j].z += (1.f / SC_Y) * hi.x; v[j].w += (1.f / SC_Y) * hi.y; } }
                else { const GAS v2u* yr = (const GAS v2u*)(Y + ((size_t)e * ER + b * CAP + r) * DM) + F.lane;
#pragma unroll
                for (int j = 0; j < 4; ++j) { const v2u w = yr[64 * j]; v[j].x += bflo(w.x); v[j].y += bfhi(w.x); v[j].z += bflo(w.y); v[j].w += bfhi(w.y); } }
            }
            float s = 0.f;
#pragma unroll
            for (int j = 0; j < 4; ++j) s += (v[j].x * v[j].x + v[j].y * v[j].y) + (v[j].z * v[j].z + v[j].w * v[j].w);
            const float rr = 1.0f / sqrtf(wave_sum(s) * (1.f / DM) + RMS_EPS);
            if (l + 1 < NLAYER) {
                GAS unsigned long long* o8 = (GAS unsigned long long*)(F.XB + (size_t)row * DM) + F.lane;
#pragma unroll
                for (int j = 0; j < 4; ++j) o8[64 * j] = (unsigned long long)pk2(v[j].x, v[j].y) | ((unsigned long long)pk2(v[j].z, v[j].w) << 32);
                if (F.lane == 0) F.RS0[row] = rr;
            } else {
                GAS f32x4* orow = (GAS f32x4*)(F.out + (size_t)row * DM) + F.lane;
#pragma unroll
                for (int j = 0; j < 4; ++j) __builtin_nontemporal_store(v[j] * rr * gr[64 * j], orow + 64 * j);
            }
        }
    }
}

struct Args { const float* in[14]; float* out; unsigned char* ws; int ph_lo, ph_hi, li, pad; };
constexpr int NPHASE = 1 + 9 * NLAYER;
template <class Tp> __device__ __forceinline__ Tp* as_global(Tp* p) { return (Tp*)(GAS Tp*)p; }
__device__ __forceinline__ void build_frame(Frame& F) {
    extern __shared__ __attribute__((aligned(16))) unsigned char lds[];
    const CAS Args* A = (const CAS Args*)__builtin_amdgcn_kernarg_segment_ptr();
    asm volatile("" : "+s"(A));
    int tid = threadIdx.x; asm volatile("" : "+v"(tid));
    F.lds = (LAS unsigned char*)lds;
    F.tid = tid; F.lane = tid & 63; F.wave = __builtin_amdgcn_readfirstlane(tid >> 6);
    F.G = gridDim.x; { const int bx = blockIdx.x; F.vcu = (F.G % 8 == 0) ? (bx % 8) * (F.G / 8) + bx / 8 : bx; }
    unsigned char* ws = as_global(A->ws);
    F.x = as_global(A->in[0]); F.mem = as_global(A->in[1]); F.mem_norm = as_global(A->in[2]); F.norm_mix = as_global(A->in[3]); F.w_in = as_global(A->in[4]); F.conv_w = as_global(A->in[5]); F.w_mem_kv = as_global(A->in[6]);
    F.w_out = as_global(A->in[7]); F.norm_ffn = as_global(A->in[8]); F.w_router = as_global(A->in[9]); F.w_gate = as_global(A->in[10]); F.w_up = as_global(A->in[11]); F.w_down = as_global(A->in[12]); F.norm_final = as_global(A->in[13]);
    F.out = as_global(A->out);
    F.WIN = (bf16*)(ws + WS_WIN); F.WKV = (bf16*)(ws + WS_WKV); F.WOUT = (bf16*)(ws + WS_WOUT); F.WGU = (bf16*)(ws + WS_WGU); F.WDN = (bf16*)(ws + WS_WDN);
    F.XB = (bf16*)(ws + WS_XB); F.X1B = (bf16*)(ws + WS_X1B); F.H = (bf16*)(ws + WS_H); F.OP = (bf16*)(ws + WS_OP); F.MIX = (bf16*)(ws + WS_MIX); F.MEMN = (bf16*)(ws + WS_MEMN); F.KVM = (bf16*)(ws + WS_KVM);
    F.XG = (bf16*)(ws + WS_XG); F.HID = (bf16*)(ws + WS_HID); F.LSE = (float*)(ws + WS_LSE); F.AFFT = (float*)(ws + WS_AFFT); F.GROW = (float*)(ws + WS_GROW); F.INV = (short*)(ws + WS_INV); F.IDX = (int*)(ws + WS_IDX); F.RS0 = (float*)(ws + WS_RS0); F.SS1 = (float*)(ws + WS_SS1); F.RS1 = (float*)(ws + WS_RS1); F.RSLOT = (float*)(ws + WS_RSLOT); F.X1F8 = ws + WS_X1F8;
}
__device__ __forceinline__ void seam_barrier() {
    extern __shared__ __attribute__((aligned(16))) unsigned char lds[];
    const CAS Args* A = (const CAS Args*)__builtin_amdgcn_kernarg_segment_ptr();
    asm volatile("" : "+s"(A));
    XcdBarrier b;
#if ONE_LAUNCH
    b.bar = as_global((unsigned*)g_barrier_words);
#else
    b.bar = (unsigned*)(as_global(A->ws) + WS_CTL) + CW_BAR + A->li * XCD_BAR_WORDS;
#endif
    b.x = xb_xcc_id(); b.st = (volatile LAS unsigned*)((LAS unsigned char*)lds + MISC_OFF) + 8;
    xcd_barrier(b);
}
__global__ void __launch_bounds__(NWAVES * 64, 2) mega_fwd(Args args) {
    extern __shared__ __attribute__((aligned(16))) unsigned char lds[];
    for (int u = threadIdx.x; u < (LDS_BYTES - LDSCTL_OFF) / 4; u += NWAVES * 64) ((LAS unsigned*)((LAS unsigned char*)lds + LDSCTL_OFF))[u] = 0u;
    __syncthreads();
    const int lo = args.ph_lo, hi = args.ph_hi;
#if ONE_LAUNCH
    if (hi - lo > 1) (void)xcd_barrier_post(as_global((unsigned*)g_barrier_words), (volatile LAS unsigned*)((LAS unsigned char*)lds + MISC_OFF) + 8);
#else
    if (hi - lo > 1) (void)xcd_barrier_post((unsigned*)(args.ws + WS_CTL) + CW_BAR + args.li * XCD_BAR_WORDS, (volatile LAS unsigned*)((LAS unsigned char*)lds + MISC_OFF) + 8);
#endif
#define IN(k) (lo <= (k) && (k) < hi)
#define SEAM(k) do { if ((k) + 1 < hi) for (int rep = 0; rep < NREP(2048); ++rep) seam_barrier(); } while (0)

    if (IN(0)) { if (SK(1)) for (int rep = 0; rep < NREP(1); ++rep) { Frame F; build_frame(F); p0_prologue(F); } SEAM(0); }
#pragma unroll 1
    for (int l = 0; l < NLAYER; ++l) {
        const int pb = 1 + 9 * l;
        if (IN(pb + 0)) {
            if (SK(2)) for (int rep = 0; rep < NREP(2); ++rep) { Frame F; build_frame(F);
              pg8::Gemm g{F.XB, F.WIN + (size_t)l * INW * DM, T, INW, DM, 1 << 30, 0, nullptr}; pg8::StaticOrder S; S.init(T, INW, F.G, (int)blockIdx.x);
              pg8::EpiBf16 E{F.H, INW, F.RS0};
              pg8::gemm_phase<pg8::EpiBf16, pg8::StaticOrder, true, true>(F.lds, g, S, E); }
            if (SK(4) && l == 0) { Frame F; build_frame(F);
              pg8::Gemm g{F.MEMN, F.WKV, NB * MEMT, 1024, DM, 1 << 30, 0, nullptr}; pg8::StaticOrder S; S.init(NB * MEMT, 1024, F.G, (int)((blockIdx.x + F.G / 2) % F.G));
              pg8::EpiBf16 E{F.KVM, 1024, nullptr};
              pg8::gemm_phase<pg8::EpiBf16, pg8::StaticOrder, true, true>(F.lds, g, S, E); }
            { const int wg0 = (l == 0) ? DEFER_WG0 : DEFER_WG1, first = (l == 0) ? NITEMS - N_DEFER0 : NITEMS - N_DEFER0 - N_DEFER1;
              if (SK(1) && (int)blockIdx.x >= wg0) { Frame F; build_frame(F);
                LAS float* scr = (LAS float*)(F.lds + F.wave * CSCR_BYTES); const int w0 = ((int)blockIdx.x - wg0) * NWAVES + F.wave;
                const int per = (l == 0) ? DEFER_PER : DEFER_PER1;
                for (int j = 0; j < per; ++j) conv_item(F, first + w0 + j * (256 - wg0) * NWAVES, scr); } }
            SEAM(pb + 0);
        }
        if (IN(pb + 1)) { if (SK(8)) for (int rep = 0; rep < NREP(8); ++rep) { Frame F; build_frame(F); p_attn_fast(F, l); } SEAM(pb + 1); }
        if (IN(pb + 2)) { if (SK(16)) for (int rep = 0; rep < NREP(16); ++rep) { Frame F; build_frame(F); p_merge_conv(F, l); } SEAM(pb + 2); }
        if (IN(pb + 3)) {
            if (SK(32)) for (int rep = 0; rep < NREP(32); ++rep) { Frame F; build_frame(F);
            pg8::Gemm g{F.MIX, F.WOUT + (size_t)l * DM * DM, T, DM, DM, 1 << 30, 0, nullptr}; pg8::StaticOrder S; S.init(T, DM, F.G, (int)blockIdx.x);
            pg8::EpiResBf16 E{F.XB, F.X1B, DM, F.SS1, GU8 ? F.X1F8 : nullptr, SC_X1};
            pg8::gemm_phase<pg8::EpiResBf16, pg8::StaticOrder, false, true>(F.lds, g, S, E); }
            SEAM(pb + 3);
        }
        if (IN(pb + 4)) { if (SK(64)) for (int rep = 0; rep < NREP(64); ++rep) { Frame F; build_frame(F); if (ROUTER_MFMA) p_router_mfma(F, l); else p_norm_router(F, l); } SEAM(pb + 4); }
        if (IN(pb + 6)) {
            if (SK(256)) for (int rep = 0; rep < NREP(256); ++rep) { Frame F; build_frame(F);
            const int e = F.vcu >> 4, b = F.vcu & 7, pm = e * 8 + b;
            LAS int* lidx = (LAS int*)(F.lds + LDSX_OFF); LAS float* lrs = (LAS float*)(F.lds + LDSX_OFF + 1024);
            p_topk_pair(F, b, e, lidx, lrs, ((F.vcu >> 3) & 1) == 0);
            pg8::ExpertOrder S; S.init(F.vcu);
            static_assert(GU8 == DN8, "expert GEMMs: both fp8 or both bf16");
            static_assert(!GU8 || (NITEMS - 2 * CV_SMALL - N_DEFER) % (256 * NWAVES) == 0, "prologue items per wave");
            if constexpr (GU8) {
              pg8::Gemm g{(const pg8::bf16_t*)F.X1F8, (const pg8::bf16_t*)((const unsigned char*)F.WGU + (size_t)l * NE * 2 * FF * DM), NE * ER, 2 * FF, DM / 2, ER / 256, (size_t)2 * FF * DM / 2, (const int*)lidx - pm * 256};
              pg8::EpiSwiGLU8 E{(unsigned char*)F.HID, FF, (const float*)lrs - pm * 256, SC_HID};
              pg8::gemm_phase<pg8::EpiSwiGLU8, pg8::ExpertOrder, true, true, true, true>(F.lds, g, S, E); }
            else { pg8::Gemm g{F.X1B, F.WGU + (size_t)l * NE * 2 * FF * DM, NE * ER, 2 * FF, DM, ER / 256, (size_t)2 * FF * DM, (const int*)lidx - pm * 256};
              pg8::EpiSwiGLU E{F.HID, FF, (const float*)lrs - pm * 256};
              pg8::gemm_phase<pg8::EpiSwiGLU, pg8::ExpertOrder, true, true, true>(F.lds, g, S, E); } }
            SEAM(pb + 6);
        }
        if (IN(pb + 7)) {
            if (SK(512)) for (int rep = 0; rep < NREP(512); ++rep) { Frame F; build_frame(F);
            pg8::StaticOrder S; S.init(NE * ER, DM, F.G, (int)blockIdx.x); pg8::EpiBf16 E{F.XG, DM, F.GROW};
            static_assert(!Y8 || DN8, "fp8 Y needs the fp8 down projection");
            if constexpr (DN8) {
              pg8::Gemm g{F.HID, (const pg8::bf16_t*)((const unsigned char*)F.WDN + (size_t)l * NE * DM * FF), NE * ER, DM, FF / 2, ER / 256, (size_t)DM * FF / 2, nullptr};
              if constexpr (Y8) { pg8::EpiF8 E8{(unsigned char*)F.XG, DM, F.GROW}; pg8::gemm_phase<pg8::EpiF8, pg8::StaticOrder, true, true, false, true>(F.lds, g, S, E8); }
              else pg8::gemm_phase<pg8::EpiBf16, pg8::StaticOrder, true, true, false, true>(F.lds, g, S, E); }
            else { pg8::Gemm g{F.HID, F.WDN + (size_t)l * NE * DM * FF, NE * ER, DM, FF, ER / 256, (size_t)DM * FF, nullptr};
              pg8::gemm_phase<pg8::EpiBf16, pg8::StaticOrder, true, true>(F.lds, g, S, E); } }
            SEAM(pb + 7);
        }
        if (IN(pb + 8)) { if (SK(1024)) for (int rep = 0; rep < NREP(1024); ++rep) { Frame F; build_frame(F); p_combine_norm<Y8>(F, l); } SEAM(pb + 8); }
    }
#undef IN
#undef SEAM
#if ONE_LAUNCH
    if (hi - lo > 1) {
        __syncthreads();
        if (threadIdx.x == 0) { unsigned* bar = as_global((unsigned*)g_barrier_words);
            if (xb_add(&bar[XB_EXIT], 1u) + 1u == gridDim.x) {
                for (unsigned j = 0; j < 16; ++j) { __hip_atomic_store(&bar[XB_XCNT(j)], 0u, RLX_AGENT); __hip_atomic_store(&bar[XB_XSUB(j)], 0u, RLX_AGENT); __hip_atomic_store(&bar[XB_XGEN(j)], 0u, RLX_AGENT); }
                __hip_atomic_store(&bar[XB_TOP], 0u, RLX_AGENT); __hip_atomic_store(&bar[XB_TOPGEN], 0u, RLX_AGENT); __hip_atomic_store(&bar[XB_TMO], 0u, RLX_AGENT); __hip_atomic_store(&bar[XB_EXIT], 0u, RLX_AGENT); } }
    }
#endif
}

extern "C" void kernel_launch(void* const* d_in, const int* in_sizes, int n_in, void* d_out, int out_size, void* d_ws, size_t ws_size, hipStream_t stream) {
    static int grid = 0;
    if (grid == 0) {
        if (n_in != 14 || in_sizes[0] != T * DM || out_size != T * DM || ws_size < WS_END) { fprintf(stderr, "kernel_launch: unexpected shapes (n_in %d, in0 %d, out %d, ws %zu); nothing launched\n", n_in, n_in > 0 ? in_sizes[0] : -1, out_size, ws_size); grid = -1; return; }
        int dev = 0, cus = 0;
        if (hipGetDevice(&dev) != hipSuccess || hipDeviceGetAttribute(&cus, hipDeviceAttributeMultiprocessorCount, dev) != hipSuccess) { grid = -1; return; }
        if (hipFuncSetAttribute((const void*)mega_fwd, hipFuncAttributeMaxDynamicSharedMemorySize, LDS_BYTES) != hipSuccess) { fprintf(stderr, "kernel_launch: hipFuncSetAttribute failed\n"); grid = -1; return; }
        (void)hipGetLastError();
        grid = cus;
        if (grid != 256) fprintf(stderr, "kernel_launch: %d CUs; this kernel is laid out for 256\n", grid);
    }
    if (grid < 0) return;
#if !ONE_LAUNCH
    (void)hipMemsetAsync((char*)d_ws + WS_CTL, 0, CTL_ZERO_BYTES, stream);
#endif
    Args a{};
    for (int i = 0; i < 14; ++i) a.in[i] = (const float*)d_in[i];
    a.out = (float*)d_out; a.ws = (unsigned char*)d_ws;
    int li = 0;
    auto mega = [&](int lo, int hi) { a.ph_lo = lo; a.ph_hi = hi; a.li = li++; hipLaunchKernelGGL(mega_fwd, dim3(grid), dim3(NWAVES * 64), LDS_BYTES, stream, a); };
#if ONE_LAUNCH
    mega(0, NPHASE);
#else
    for (int k = 0; k < NPHASE; ++k) mega(k, k + 1);
#endif
}
```

```cpp
#include <hip/hip_runtime.h>
#include <cstdio>
#include <cstdint>
#include <cmath>
#include <type_traits>

#ifndef ONE_LAUNCH
#define ONE_LAUNCH 1
#endif
#ifndef ROUTER_MFMA
#define ROUTER_MFMA 1
#endif
#ifndef SKIPMASK
#define SKIPMASK 0
#endif
#define SK(b) (!((SKIPMASK) & (b)))
#ifndef DUPMASK
#define DUPMASK 0
#endif
#define NREP(b) (((DUPMASK) & (b)) ? 2 : 1)

#define GAS __attribute__((address_space(1)))
#define LAS __attribute__((address_space(3)))
#define CAS __attribute__((address_space(4)))
typedef unsigned short bf16;
typedef unsigned v4u __attribute__((ext_vector_type(4)));
typedef unsigned v2u __attribute__((ext_vector_type(2)));
typedef float f32x4 __attribute__((ext_vector_type(4)));
typedef float f32x16 __attribute__((ext_vector_type(16)));
typedef short bf16x8 __attribute__((ext_vector_type(8)));
typedef short s16x4 __attribute__((ext_vector_type(4)));

constexpr int NB = 8, SEQ = 2048, DM = 1024, NLAYER = 2, MEMT = 256, INW = 2560;
constexpr int T = NB * SEQ;
constexpr int C_XC = 0, C_BG = 384, C_CG = 768, C_Q = 1152, C_K = 1536, C_V = 1920, C_QM = 2304;
constexpr int NDH = 6, NMH = 4, CONVC = 384;
constexpr int NE = 16, FF = 2048, CAP = 256, ER = NB * CAP;
constexpr float RMS_EPS = 1e-6f;
constexpr float LOG2E = 1.4426950408889634f;

constexpr size_t MiB = 1u << 20;
constexpr size_t WS_CTL = 0, CTL_ZERO_BYTES = 1 * MiB;
constexpr size_t WS_WIN = 2 * MiB;
constexpr size_t WS_WKV = 12 * MiB;
constexpr size_t WS_WOUT = 14 * MiB;
constexpr size_t WS_WGU = 18 * MiB;
constexpr size_t WS_WDN = 274 * MiB;
constexpr size_t WS_XB = 402 * MiB;
constexpr size_t WS_H = 434 * MiB;
constexpr size_t WS_OP = 514 * MiB;
constexpr size_t WS_LSE = 550 * MiB;
constexpr size_t WS_MIX = 552 * MiB;
constexpr size_t WS_MEMN = 584 * MiB;
constexpr size_t WS_KVM = 588 * MiB;
constexpr size_t WS_AFFT = 592 * MiB;
constexpr size_t WS_INV = 593 * MiB;
constexpr size_t WS_GROW = 594 * MiB;
constexpr size_t WS_IDX = 595 * MiB;
constexpr size_t WS_XG = 596 * MiB;
constexpr size_t WS_HID = 660 * MiB;
constexpr size_t WS_X1B = 788 * MiB;
constexpr size_t WS_RS0 = 820 * MiB;
constexpr size_t WS_SS1 = 821 * MiB;
constexpr size_t WS_RS1 = 823 * MiB;
constexpr size_t WS_RSLOT = 824 * MiB;
constexpr size_t WS_X1F8 = 825 * MiB;
constexpr size_t WS_END = 841 * MiB;

constexpr int CW_BAR = 4096;
#define XCD_BAR_WORDS 3456
constexpr int MAX_LAUNCH = 24;
static_assert((CW_BAR + MAX_LAUNCH * XCD_BAR_WORDS) * 4 <= (int)CTL_ZERO_BYTES, "ctl");

constexpr int RING_BYTES = 131072, LDSCTL_OFF = 155648  , MISC_OFF = LDSCTL_OFF + 320, LDSX_OFF = LDSCTL_OFF + 4096  , LDS_BYTES = 163840  ;
constexpr int NWAVES = 8;

#define RLX_AGENT __ATOMIC_RELAXED, __HIP_MEMORY_SCOPE_AGENT
#define LDS_WAIT() asm volatile("s_waitcnt lgkmcnt(0)" ::: "memory")
__device__ __forceinline__ unsigned f2bf(float f) { unsigned u = __builtin_bit_cast(unsigned, f); return (u + 0x7fffu + ((u >> 16) & 1u)) >> 16; }
__device__ __forceinline__ unsigned pk2(float lo, float hi) { return f2bf(lo) | (f2bf(hi) << 16); }
__device__ __forceinline__ unsigned cvtpk_s(float lo, float hi) { typedef float f2 __attribute__((ext_vector_type(2))); typedef __bf16 b2 __attribute__((ext_vector_type(2))); f2 v = {lo, hi}; b2 b = __builtin_convertvector(v, b2); return __builtin_bit_cast(unsigned, b); }
__device__ __forceinline__ float bflo(unsigned w) { return __builtin_bit_cast(float, w << 16); }
__device__ __forceinline__ float bfhi(unsigned w) { return __builtin_bit_cast(float, w & 0xffff0000u); }
__device__ __forceinline__ float bf2f(bf16 v) { return __builtin_bit_cast(float, (unsigned)v << 16); }
__device__ __forceinline__ float wave_sum(float v) {
#pragma unroll
    for (int o = 1; o < 64; o <<= 1) v += __shfl_xor(v, o);
    return v;
}

namespace pg8 {
#define PG8_LAS __attribute__((address_space(3)))
typedef unsigned short bf16_t;
typedef short bf16x8 __attribute__((ext_vector_type(8)));
typedef float f32x4 __attribute__((ext_vector_type(4)));
typedef unsigned u32x4 __attribute__((ext_vector_type(4)));
typedef unsigned u32x2 __attribute__((ext_vector_type(2)));
constexpr int BM = 256, BK = 64, HALF = 128, HTB = HALF * BK * 2  , STAGE_BYTES = 8 * HTB, NXCD = 8, WGM = 8;

__host__ __device__ __forceinline__ int lds_byte(int r, int c) { const int st = (r >> 4) * 2 + (c >> 5), rr = r & 15, cc = c & 31, ob = rr * 64 + cc * 2; return st * 1024 + (ob ^ (((ob >> 9) & 1) << 5)); }
__host__ __device__ __forceinline__ void stage_rc(int b, int& R, int& C) { const int st = b / 1024, sb = b % 1024, swz = sb ^ (((sb >> 9) & 1) << 5); R = (st >> 1) * 16 + swz / 64; C = (st & 1) * 32 + (swz % 64) / 2; }
__host__ __device__ __forceinline__ int perm32(int rho) { const int n = rho >> 4, i = rho & 15; return 8 * (i >> 2) + 4 * n + (i & 3); }

typedef int i32x4 __attribute__((ext_vector_type(4)));
typedef int i32x8 __attribute__((ext_vector_type(8)));
__device__ __forceinline__ i32x8 cat8(bf16x8 a, bf16x8 b) { const i32x4 x = __builtin_bit_cast(i32x4, a), y = __builtin_bit_cast(i32x4, b); return __builtin_shufflevector(x, y, 0, 1, 2, 3, 4, 5, 6, 7); }
__device__ __forceinline__ unsigned pk4_e4m3(float a, float b, float c, float d) {
    a = __builtin_amdgcn_fmed3f(a, -448.f, 448.f); b = __builtin_amdgcn_fmed3f(b, -448.f, 448.f); c = __builtin_amdgcn_fmed3f(c, -448.f, 448.f); d = __builtin_amdgcn_fmed3f(d, -448.f, 448.f);
    int w = __builtin_amdgcn_cvt_pk_fp8_f32(a, b, 0, false); w = __builtin_amdgcn_cvt_pk_fp8_f32(c, d, w, true); return (unsigned)w; }
__device__ __forceinline__ void mfma8(f32x4& acc, i32x8 a, i32x8 b) { asm volatile("v_mfma_f32_16x16x128_f8f6f4 %0, %1, %2, %0" : "+v"(acc) : "v"(a), "v"(b)); }
struct Unit { int pm, pn; };
struct Gemm { const bf16_t* A; const bf16_t* Bt; int M, N, K; int gm; size_t gstride; const int* aidx; };

struct StaticOrder {
    int nM, nN, nwg, G, c;
    __host__ __device__ void init(int M, int N, int G_, int c_) { nM = M / BM; nN = N / BM; nwg = nM * nN; G = G_; c = c_; }
    __host__ __device__ bool next(int i, Unit& u) const {
        const long L = (long)i * G + c; if (L >= nwg) return false;
        int wgid = (int)L; { const int q = nwg / NXCD, r = nwg % NXCD, xcd = wgid % NXCD, off = wgid / NXCD; wgid = (xcd < r ? xcd * (q + 1) : r * (q + 1) + (xcd - r) * q) + off; }
        const int nig = WGM * nN, gid = wgid / nig, fm = gid * WGM, gsz = (nM - fm) < WGM ? (nM - fm) : WGM;
        u.pm = fm + ((wgid % nig) % gsz); u.pn = (wgid % nig) / gsz; return true;
    }
    __device__ __forceinline__ void a_ready(const Unit&) const {}
    __device__ __forceinline__ void done(const Unit&) const {}
};

struct ExpertOrder {
    int pm, pn0;
    __device__ __forceinline__ void init(int vcu) { pm = (vcu >> 4) * 8 + (vcu & 7); pn0 = ((vcu >> 3) & 1) * 8; }
    __device__ __forceinline__ bool next(int i, Unit& u) const { if (i >= 8) return false; u.pm = pm; u.pn = pn0 + i; return true; }
    __device__ __forceinline__ void a_ready(const Unit&) const {}
    __device__ __forceinline__ void done(const Unit&) const {}
};

__device__ __forceinline__ unsigned cvt_pk_bf16(float lo, float hi) { unsigned r; asm volatile("v_cvt_pk_bf16_f32 %0, %1, %2" : "=v"(r) : "v"(lo), "v"(hi)); return r; }

struct EpiBf16 {
    static constexpr bool PERM = true, AFTER_DRAIN = false;
    bf16_t* O; int ldc; const float* rscale;
    __device__ __forceinline__ void operator()(const f32x4 (&acc)[2][2][4][2], const Unit& u, int wr, int wc, int fr, int fq) const {
        int row0 = u.pm * BM + wr * 64 + fr; asm volatile("" : "+v"(row0));
        const int col0 = u.pn * BM + wc * 32 + 8 * fq;
#pragma unroll
        for (int ai = 0; ai < 2; ++ai)
#pragma unroll
            for (int m = 0; m < 4; ++m) { const int row = row0 + ai * HALF + m * 16; bf16_t* rowp = O + (size_t)row * ldc + col0;
                const float sc = rscale ? rscale[row] : 1.f;
#pragma unroll
                for (int bj = 0; bj < 2; ++bj) { const f32x4 v0 = acc[ai][bj][m][0] * sc, v1 = acc[ai][bj][m][1] * sc;
                    u32x4 w; w.x = cvt_pk_bf16(v0[0], v0[1]); w.y = cvt_pk_bf16(v0[2], v0[3]); w.z = cvt_pk_bf16(v1[0], v1[1]); w.w = cvt_pk_bf16(v1[2], v1[3]);
                    *(u32x4*)(rowp + bj * HALF) = w; } }
    }
};
struct EpiF8 {
    static constexpr bool PERM = true, AFTER_DRAIN = false;
    unsigned char* O; int ldc; const float* rscale;
    __device__ __forceinline__ void operator()(const f32x4 (&acc)[2][2][4][2], const Unit& u, int wr, int wc, int fr, int fq) const {
        int row0 = u.pm * BM + wr * 64 + fr; asm volatile("" : "+v"(row0));
        const int col0 = u.pn * BM + wc * 32 + 8 * fq;
#pragma unroll
        for (int ai = 0; ai < 2; ++ai)
#pragma unroll
            for (int m = 0; m < 4; ++m) { const int row = row0 + ai * HALF + m * 16; unsigned char* rowp = O + (size_t)row * ldc + col0;
                const float sc = rscale[row];
#pragma unroll
                for (int bj = 0; bj < 2; ++bj) { const f32x4 v0 = acc[ai][bj][m][0] * sc, v1 = acc[ai][bj][m][1] * sc;
                    u32x2 w; w.x = pk4_e4m3(v0[0], v0[1], v0[2], v0[3]); w.y = pk4_e4m3(v1[0], v1[1], v1[2], v1[3]);
                    *(u32x2*)(rowp + bj * HALF) = w; } }
    }
};
struct EpiResBf16 {
    static constexpr bool PERM = true, AFTER_DRAIN = false;
    const bf16_t* base; bf16_t* out; int ldc; float* ss; unsigned char* o8; float s8;
    __device__ __forceinline__ void operator()(const f32x4 (&acc)[2][2][4][2], const Unit& u, int wr, int wc, int fr, int fq) const {
        int row0 = u.pm * BM + wr * 64 + fr; asm volatile("" : "+v"(row0));
        const int col0 = u.pn * BM + wc * 32 + 8 * fq;
#pragma unroll
        for (int ai = 0; ai < 2; ++ai) {
            u32x4 b[4][2];
#pragma unroll
            for (int m = 0; m < 4; ++m)
#pragma unroll
                for (int bj = 0; bj < 2; ++bj) b[m][bj] = *(const u32x4*)(base + (size_t)(row0 + ai * HALF + m * 16) * ldc + col0 + bj * HALF);
#pragma unroll
            for (int m = 0; m < 4; ++m) { const int row = row0 + ai * HALF + m * 16; float q = 0.f;
#pragma unroll
                for (int bj = 0; bj < 2; ++bj) { const u32x4 bb = b[m][bj]; f32x4 v0 = acc[ai][bj][m][0], v1 = acc[ai][bj][m][1];
                    v0[0] += __builtin_bit_cast(float, bb.x << 16); v0[1] += __builtin_bit_cast(float, bb.x & 0xffff0000u); v0[2] += __builtin_bit_cast(float, bb.y << 16); v0[3] += __builtin_bit_cast(float, bb.y & 0xffff0000u);
                    v1[0] += __builtin_bit_cast(float, bb.z << 16); v1[1] += __builtin_bit_cast(float, bb.z & 0xffff0000u); v1[2] += __builtin_bit_cast(float, bb.w << 16); v1[3] += __builtin_bit_cast(float, bb.w & 0xffff0000u);
                    q += (v0[0] * v0[0] + v0[1] * v0[1]) + (v0[2] * v0[2] + v0[3] * v0[3]) + (v1[0] * v1[0] + v1[1] * v1[1]) + (v1[2] * v1[2] + v1[3] * v1[3]);
                    u32x4 w; w.x = cvt_pk_bf16(v0[0], v0[1]); w.y = cvt_pk_bf16(v0[2], v0[3]); w.z = cvt_pk_bf16(v1[0], v1[1]); w.w = cvt_pk_bf16(v1[2], v1[3]);
                    *(u32x4*)(out + (size_t)row * ldc + col0 + bj * HALF) = w;
                    if (o8) { u32x2 w8; w8.x = pk4_e4m3(v0[0] * s8, v0[1] * s8, v0[2] * s8, v0[3] * s8); w8.y = pk4_e4m3(v1[0] * s8, v1[1] * s8, v1[2] * s8, v1[3] * s8);
                        *(u32x2*)(o8 + (size_t)row * ldc + col0 + bj * HALF) = w8; } }
                q += __shfl_xor(q, 16); q += __shfl_xor(q, 32);
                if (fq == 0) ss[(size_t)row * 16 + 4 * u.pn + wc] = q; }
        }
    }
};
__device__ __forceinline__ float silu_mul(float g, float u) { return g * __builtin_amdgcn_rcpf(1.0f + __builtin_amdgcn_exp2f(-1.4426950408889634f * g)) * u; }
struct EpiSwiGLU {
    static constexpr bool PERM = true, AFTER_DRAIN = false;
    bf16_t* O; int ldc; const float* rscale;
    __device__ __forceinline__ void operator()(const f32x4 (&acc)[2][2][4][2], const Unit& u, int wr, int wc, int fr, int fq) const {
        int row0 = u.pm * BM + wr * 64 + fr; asm volatile("" : "+v"(row0));
        const int col0 = u.pn * HALF + wc * 32 + 8 * fq;
#pragma unroll
        for (int ai = 0; ai < 2; ++ai)
#pragma unroll
            for (int m = 0; m < 4; ++m) { const int row = row0 + ai * HALF + m * 16; bf16_t* rowp = O + (size_t)row * ldc + col0; const float sc = rscale[row];
                const f32x4 g0 = acc[ai][0][m][0] * sc, g1 = acc[ai][0][m][1] * sc, u0 = acc[ai][1][m][0] * sc, u1 = acc[ai][1][m][1] * sc;
                u32x4 w; w.x = cvt_pk_bf16(silu_mul(g0[0], u0[0]), silu_mul(g0[1], u0[1])); w.y = cvt_pk_bf16(silu_mul(g0[2], u0[2]), silu_mul(g0[3], u0[3]));
                w.z = cvt_pk_bf16(silu_mul(g1[0], u1[0]), silu_mul(g1[1], u1[1])); w.w = cvt_pk_bf16(silu_mul(g1[2], u1[2]), silu_mul(g1[3], u1[3]));
                *(u32x4*)rowp = w; }
    }
};

struct EpiSwiGLU8 {
    static constexpr bool PERM = true, AFTER_DRAIN = false;
    unsigned char* O; int ldc; const float* rscale; float oscale;
    __device__ __forceinline__ void operator()(const f32x4 (&acc)[2][2][4][2], const Unit& u, int wr, int wc, int fr, int fq) const {
        int row0 = u.pm * BM + wr * 64 + fr; asm volatile("" : "+v"(row0));
        const int col0 = u.pn * HALF + wc * 32 + 8 * fq;
#pragma unroll
        for (int ai = 0; ai < 2; ++ai)
#pragma unroll
            for (int m = 0; m < 4; ++m) { const int row = row0 + ai * HALF + m * 16; unsigned char* rowp = O + (size_t)row * ldc + col0; const float sc = rscale[row], su = sc * oscale;
                const f32x4 g0 = acc[ai][0][m][0] * sc, g1 = acc[ai][0][m][1] * sc, u0 = acc[ai][1][m][0] * su, u1 = acc[ai][1][m][1] * su;
                u32x2 w; w.x = pk4_e4m3(silu_mul(g0[0], u0[0]), silu_mul(g0[1], u0[1]), silu_mul(g0[2], u0[2]), silu_mul(g0[3], u0[3]));
                w.y = pk4_e4m3(silu_mul(g1[0], u1[0]), silu_mul(g1[1], u1[1]), silu_mul(g1[2], u1[2]), silu_mul(g1[3], u1[3]));
                *(u32x2*)rowp = w; }
    }
};

template <class Epi, class Sched, bool ALIGN_EPI = false, bool SP2 = false, bool GATHER = false, bool FP8 = false>
__device__ __forceinline__ void gemm_phase(PG8_LAS unsigned char* lds, const Gemm g, const Sched& S, const Epi& E) {
    int tid_ = threadIdx.x; asm volatile("" : "+v"(tid_));
    const int tid = tid_, wid = __builtin_amdgcn_readfirstlane(tid >> 6), lane = tid & 63, wr = wid >> 2, wc = wid & 3, fr = lane & 15, fq = lane >> 4;
    const int K = g.K, nt = K / BK;
    unsigned voffA[2], voffA1[2], voffB[2];
    const size_t hstep = (size_t)HALF * K * 2;
    Unit cur, nxt; int ui = 0;
    if (!S.next(0, cur)) return;
#pragma unroll
    for (int i = 0; i < 2; ++i) { int R, C; stage_rc(tid * 16 + i * 8192, R, C); const int Rb = Epi::PERM ? ((R & ~31) + perm32(R & 31)) : R;
        if constexpr (GATHER) { const int r0 = g.aidx[cur.pm * BM + R], r1 = g.aidx[cur.pm * BM + HALF + R]; voffA[i] = (unsigned)(r0 * K + C) * 2u; voffA1[i] = (unsigned)(r1 * K + C) * 2u; }
        else { voffA[i] = (unsigned)(R * K + C) * 2u; voffA1[i] = voffA[i] + (unsigned)hstep; }
        voffB[i] = (unsigned)(Rb * K + C) * 2u; }
    const size_t kstep = (size_t)(BK * 2);
    const size_t tstep = 2 * hstep;
    const size_t gbytes = g.gstride * 2;
    const unsigned ldsw = (unsigned)wid * 1024u;
    const int aoff = lds_byte(wr * 64 + fr, fq * 8), boff = lds_byte(wc * 32 + fr, fq * 8);
#define PG8_SA(b, h) (((b) * 2 + (h)) * HTB)
#define PG8_SB(b, h) ((4 + (b) * 2 + (h)) * HTB)
#define PG8_STAGE(bufoff, gbase, voff) do { _Pragma("unroll") for (int _i = 0; _i < 2; ++_i) \
        __builtin_amdgcn_global_load_lds((const unsigned*)((const char*)(gbase) + (voff)[_i]), (PG8_LAS unsigned*)(lds + (bufoff) + ldsw + _i * 8192), 16, 0, 0); } while (0)
#define PG8_LDA(dst, b, h) do { _Pragma("unroll") for (int m = 0; m < 4; ++m) _Pragma("unroll") for (int k = 0; k < 2; ++k) dst[m][k] = *(const PG8_LAS bf16x8*)(lds + PG8_SA(b, h) + aoff + m * 2048 + k * 1024); } while (0)
#define PG8_LDB(dst, b, h) do { _Pragma("unroll") for (int n = 0; n < 2; ++n) _Pragma("unroll") for (int k = 0; k < 2; ++k) dst[n][k] = *(const PG8_LAS bf16x8*)(lds + PG8_SB(b, h) + boff + n * 2048 + k * 1024); } while (0)
#define PG8_MMA(ai, bj, At, Bt) do { __builtin_amdgcn_s_setprio(1); \
        if constexpr (FP8) { _Pragma("unroll") for (int m = 0; m < 4; ++m) _Pragma("unroll") for (int n = 0; n < 2; ++n) \
            mfma8(acc[ai][bj][m][n], cat8(Bt[n][0], Bt[n][1]), cat8(At[m][0], At[m][1])); } \
        else { _Pragma("unroll") for (int m = 0; m < 4; ++m) _Pragma("unroll") for (int n = 0; n < 2; ++n) _Pragma("unroll") for (int k = 0; k < 2; ++k) \
            acc[ai][bj][m][n] = __builtin_amdgcn_mfma_f32_16x16x32_bf16(Bt[n][k], At[m][k], acc[ai][bj][m][n], 0, 0, 0); } \
        __builtin_amdgcn_s_setprio(0); } while (0)
#define PG8_WAIT_V(n) asm volatile("s_waitcnt vmcnt(" #n ")" ::: "memory")
#define PG8_WAIT_L(n) asm volatile("s_waitcnt lgkmcnt(" #n ")" ::: "memory")
#define PG8_BAR __builtin_amdgcn_s_barrier()
#define PG8_SCHED __builtin_amdgcn_sched_barrier(0)
    f32x4 acc[2][2][4][2];
#pragma unroll
    for (int a = 0; a < 2; ++a)
#pragma unroll
        for (int b = 0; b < 2; ++b)
#pragma unroll
            for (int m = 0; m < 4; ++m)
#pragma unroll
                for (int n = 0; n < 2; ++n) acc[a][b][m][n] = (f32x4){0.f, 0.f, 0.f, 0.f};
    bf16x8 At[4][2], B0[2][2], B1[2][2];
    const char* cA = (const char*)g.A + (GATHER ? (size_t)0 : (size_t)cur.pm * tstep); const char* cB = (const char*)g.Bt + (size_t)(cur.pm / g.gm) * gbytes + (size_t)cur.pn * tstep;
    S.a_ready(cur);
    if constexpr (SP2) {
        PG8_STAGE(PG8_SB(0, 0), cB, voffB); PG8_STAGE(PG8_SB(0, 1), cB + hstep, voffB); PG8_STAGE(PG8_SA(0, 0), cA, voffA); PG8_STAGE(PG8_SA(0, 1), cA, voffA1);
        if (wr == 1) PG8_BAR;
        PG8_WAIT_V(2); PG8_BAR;
        PG8_STAGE(PG8_SB(1, 0), cB + kstep, voffB); PG8_STAGE(PG8_SA(1, 0), cA + kstep, voffA); PG8_STAGE(PG8_SB(1, 1), cB + hstep + kstep, voffB);
        PG8_WAIT_V(6); PG8_BAR;
    } else {
        PG8_STAGE(PG8_SB(0, 0), cB, voffB); PG8_STAGE(PG8_SA(0, 0), cA, voffA); PG8_STAGE(PG8_SB(0, 1), cB + hstep, voffB); PG8_STAGE(PG8_SA(0, 1), cA, voffA1);
        if (wr == 1) PG8_BAR;
        PG8_WAIT_V(4); PG8_BAR;
        PG8_STAGE(PG8_SB(1, 0), cB + kstep, voffB); PG8_STAGE(PG8_SA(1, 0), cA + kstep, voffA); PG8_STAGE(PG8_SB(1, 1), cB + hstep + kstep, voffB);
        PG8_WAIT_V(6); PG8_BAR;
    }
    for (;;) {
        const bool has_next = S.next(ui + 1, nxt);
        const char* nA = (has_next && !GATHER) ? (const char*)g.A + (size_t)nxt.pm * tstep : cA; const char* nB = has_next ? (const char*)g.Bt + (size_t)(nxt.pm / g.gm) * gbytes + (size_t)nxt.pn * tstep : cB;
        for (int t = 0; t < nt; t += 2) {
            const bool last = (t == nt - 2);
            const char* a1 = cA + (size_t)(t + 1) * kstep;
            const char* a2 = last ? nA : cA + (size_t)(t + 2) * kstep; const char* b2 = last ? nB : cB + (size_t)(t + 2) * kstep;
            const char* a3 = a2 + kstep; const char* b3 = b2 + kstep;
            if (last && has_next) S.a_ready(nxt);
            if constexpr (SP2) {
            PG8_LDB(B0, 0, 0); PG8_LDB(B1, 0, 1); PG8_SCHED; PG8_LDA(At, 0, 0); PG8_STAGE(PG8_SA(1, 1), a1, voffA1);
            PG8_WAIT_V(8); PG8_WAIT_L(0); PG8_BAR; PG8_MMA(0, 0, At, B0); PG8_MMA(0, 1, At, B1); PG8_BAR; PG8_SCHED;
            PG8_LDA(At, 0, 1); PG8_STAGE(PG8_SB(0, 0), b2, voffB); PG8_STAGE(PG8_SB(0, 1), b2 + hstep, voffB); PG8_STAGE(PG8_SA(0, 0), a2, voffA);
            PG8_WAIT_V(8); PG8_WAIT_L(0); PG8_BAR; PG8_MMA(1, 0, At, B0); PG8_MMA(1, 1, At, B1); PG8_BAR; PG8_SCHED;
            PG8_LDB(B0, 1, 0); PG8_LDB(B1, 1, 1); PG8_SCHED; PG8_LDA(At, 1, 0); PG8_STAGE(PG8_SA(0, 1), a2, voffA1);
            PG8_WAIT_V(8); PG8_WAIT_L(0); PG8_BAR; PG8_MMA(0, 0, At, B0); PG8_MMA(0, 1, At, B1); PG8_BAR; PG8_SCHED;
            PG8_LDA(At, 1, 1); PG8_STAGE(PG8_SB(1, 0), b3, voffB); PG8_STAGE(PG8_SB(1, 1), b3 + hstep, voffB); PG8_STAGE(PG8_SA(1, 0), a3, voffA);
            PG8_WAIT_V(8); PG8_WAIT_L(0); PG8_BAR; PG8_MMA(1, 0, At, B0); PG8_MMA(1, 1, At, B1); PG8_BAR; PG8_SCHED;
            } else {
            PG8_LDB(B0, 0, 0); PG8_SCHED; PG8_LDA(At, 0, 0); PG8_STAGE(PG8_SA(1, 1), a1, voffA1);
            PG8_WAIT_L(8); PG8_BAR; PG8_WAIT_L(0); PG8_MMA(0, 0, At, B0); PG8_BAR; PG8_SCHED;
            PG8_LDB(B1, 0, 1); PG8_STAGE(PG8_SB(0, 0), b2, voffB);
            PG8_BAR; PG8_WAIT_L(0); PG8_MMA(0, 1, At, B1); PG8_BAR;
            PG8_LDA(At, 0, 1); PG8_STAGE(PG8_SA(0, 0), a2, voffA);
            PG8_BAR; PG8_WAIT_L(0); PG8_MMA(1, 0, At, B0); PG8_BAR; PG8_SCHED;
            PG8_STAGE(PG8_SB(0, 1), b2 + hstep, voffB);
            PG8_WAIT_V(6); PG8_BAR; PG8_MMA(1, 1, At, B1); PG8_BAR;
            PG8_LDB(B0, 1, 0); PG8_SCHED; PG8_LDA(At, 1, 0); PG8_STAGE(PG8_SA(0, 1), a2, voffA1);
            PG8_WAIT_L(8); PG8_BAR; PG8_WAIT_L(0); PG8_MMA(0, 0, At, B0); PG8_BAR; PG8_SCHED;
            PG8_LDB(B1, 1, 1); PG8_STAGE(PG8_SB(1, 0), b3, voffB);
            PG8_BAR; PG8_WAIT_L(0); PG8_MMA(0, 1, At, B1); PG8_BAR;
            PG8_LDA(At, 1, 1); PG8_STAGE(PG8_SA(1, 0), a3, voffA);
            PG8_BAR; PG8_WAIT_L(0); PG8_MMA(1, 0, At, B0); PG8_BAR; PG8_SCHED;
            PG8_STAGE(PG8_SB(1, 1), b3 + hstep, voffB);
            PG8_WAIT_V(6); PG8_BAR; PG8_MMA(1, 1, At, B1); PG8_BAR;
            }
        }
        if constexpr (FP8) asm volatile("s_nop 15\n\ts_nop 15" ::: "memory");
        if constexpr (ALIGN_EPI) { if (wr == 0) PG8_BAR; }
        if constexpr (!Epi::AFTER_DRAIN) { E(acc, cur, wr, wc, fr, fq); S.done(cur); }
        if (!has_next) break;
#pragma unroll
        for (int a = 0; a < 2; ++a)
#pragma unroll
            for (int b = 0; b < 2; ++b)
#pragma unroll
                for (int m = 0; m < 4; ++m)
#pragma unroll
                    for (int n = 0; n < 2; ++n) acc[a][b][m][n] = (f32x4){0.f, 0.f, 0.f, 0.f};
        cur = nxt; cA = nA; cB = nB; ++ui;
        if constexpr (ALIGN_EPI) { if (wr == 1) PG8_BAR; }
    }
    PG8_WAIT_V(0);
    if constexpr (!ALIGN_EPI) { if (wr == 0) PG8_BAR; }
    PG8_BAR;
#undef PG8_SA
#undef PG8_SB
#undef PG8_STAGE
#undef PG8_LDA
#undef PG8_LDB
#undef PG8_MMA
#undef PG8_WAIT_V
#undef PG8_WAIT_L
#undef PG8_BAR
#undef PG8_SCHED
}
}

typedef GAS unsigned gu32;
#define XB_TMO      128
#define XB_XCNT(j)  (256  + 64 * (j))
#define XB_XSUB(j)  (1280 + 64 * (j))
#define XB_XGEN(j)  (2304 + 64 * (j))
#define XB_TOP      3328
#define XB_TOPGEN   3392
#define XB_SPIN_CAP (1u << 20)

__device__ __forceinline__ unsigned xb_ld(unsigned* p)              { return __hip_atomic_load(p, __ATOMIC_RELAXED, __HIP_MEMORY_SCOPE_AGENT); }
__device__ __forceinline__ unsigned xb_add(unsigned* p, unsigned v) { return __hip_atomic_fetch_add(p, v, __ATOMIC_RELAXED, __HIP_MEMORY_SCOPE_AGENT); }
__device__ __forceinline__ unsigned xb_xcc_id() { return (unsigned)__builtin_amdgcn_s_getreg((3 << 11) | 20) & 0xFu; }
#define XB_SPIN(cond, bar) do { unsigned _sp = 0; while (cond) { __builtin_amdgcn_s_sleep(1); \
    if ((++_sp & 255u) == 0u) { if (xb_ld(&(bar)[XB_TMO])) break; if (_sp > XB_SPIN_CAP) { atomicAdd(&(bar)[XB_TMO], 1u); break; } } } } while (0)

#define XB_EXIT     3456
#if ONE_LAUNCH
__device__ unsigned g_barrier_words[XB_EXIT + 64];
#endif
struct XcdBarrier { unsigned* bar; unsigned x; volatile LAS unsigned* st; };
__device__ __forceinline__ XcdBarrier xcd_barrier_post(unsigned* bar, volatile LAS unsigned* st) {
    XcdBarrier b; b.bar = bar; b.x = xb_xcc_id(); b.st = st;
    if (threadIdx.x == 0) (void)xb_add(&bar[XB_XCNT(b.x)], 1u);
    return b;
}
__device__ __forceinline__ void xcd_barrier_complete(unsigned* bar, unsigned x, unsigned& nloc, unsigned& nx) {
    const unsigned G = gridDim.x * gridDim.y * gridDim.z;
    unsigned sum, cnt, mine, sp = 0u;
    for (;;) {
        sum = 0u; cnt = 0u; mine = 0u;
#pragma unroll
        for (unsigned j = 0; j < 16; ++j) { const unsigned c = xb_ld(&bar[XB_XCNT(j)]); sum += c; cnt += (c > 0u) ? 1u : 0u; mine = (j == x) ? c : mine; }
        if (sum == G) break;
        __builtin_amdgcn_s_sleep(1);
        if ((++sp & 255u) == 0u) { if (xb_ld(&bar[XB_TMO])) break; if (sp > XB_SPIN_CAP) { atomicAdd(&bar[XB_TMO], 1u); break; } }
    }
    nloc = mine > 0u ? mine : 1u; nx = cnt > 0u ? cnt : 1u;
}
__device__ __forceinline__ void xcd_barrier(const XcdBarrier& b) {
    asm volatile("s_waitcnt vmcnt(0)" ::: "memory");
    __syncthreads();
    if (threadIdx.x == 0) {
        unsigned* bar = b.bar;
        __builtin_amdgcn_s_waitcnt(0);
        unsigned nloc = b.st[0], nx = b.st[1];
        if (nloc == 0u) { xcd_barrier_complete(bar, b.x, nloc, nx); b.st[0] = nloc; b.st[1] = nx; }
        const unsigned old = xb_add(&bar[XB_XSUB(b.x)], 1u);
        const unsigned gen = old / nloc;
        if (old + 1u == (gen + 1u) * nloc) {
            __builtin_amdgcn_fence(__ATOMIC_RELEASE, "agent");
            asm volatile("s_waitcnt vmcnt(0)" ::: "memory");
            const unsigned og = xb_add(&bar[XB_TOP], 1u);
            const unsigned tg = og / nx;
            if (og + 1u == (tg + 1u) * nx) xb_add(&bar[XB_TOPGEN], 1u);
            else XB_SPIN(xb_ld(&bar[XB_TOPGEN]) == tg, bar);
            __builtin_amdgcn_fence(__ATOMIC_ACQUIRE, "agent");
            xb_add(&bar[XB_XGEN(b.x)], 1u);
            asm volatile("s_waitcnt vmcnt(0)" ::: "memory");
        } else {
            XB_SPIN(xb_ld(&bar[XB_XGEN(b.x)]) == gen, bar);
            __builtin_amdgcn_fence(__ATOMIC_ACQUIRE, "agent");
            asm volatile("s_waitcnt vmcnt(0)" ::: "memory");
        }
    }
    __syncthreads();
}

struct Frame {
    LAS unsigned char* lds;
    int tid, lane, wave, vcu, G;
    const float *x, *mem, *mem_norm, *norm_mix, *w_in, *conv_w, *w_mem_kv, *w_out, *norm_ffn, *w_router, *w_gate, *w_up, *w_down, *norm_final;
    float* out;
    bf16 *WIN, *WKV, *WOUT, *WGU, *WDN, *XB, *X1B, *H, *OP, *MIX, *MEMN, *KVM, *XG, *HID;
    float *LSE, *AFFT, *GROW, *RS0, *SS1, *RS1, *RSLOT; short* INV; int* IDX; unsigned char* X1F8;
};

__device__ __forceinline__ void tr_item(const float* W, int K, int N, bf16* WT, int mode, const float* gk, LAS float* scr, int item, int lane) {
    const int nblk = N / 32, kb = item / nblk, nb = item % nblk, k0 = 64 * kb, n0 = 32 * nb;
    const int drow0 = (mode == 0) ? n0 : ((n0 >> 7) * 256 + (n0 & 127) + (mode == 2 ? 128 : 0));
    { f32x4 w[8];
#pragma unroll
      for (int i = 0; i < 8; ++i) w[i] = __builtin_nontemporal_load((const GAS f32x4*)(W + (size_t)(k0 + 8 * i + (lane >> 3)) * N + n0 + 4 * (lane & 7)));
#pragma unroll
      for (int i = 0; i < 8; ++i) { const float gg = gk ? gk[k0 + 8 * i + (lane >> 3)] : 1.f; LAS float* d = scr + (8 * i + (lane >> 3)) * 33 + 4 * (lane & 7); d[0] = w[i].x * gg; d[1] = w[i].y * gg; d[2] = w[i].z * gg; d[3] = w[i].w * gg; } }
    LDS_WAIT(); asm volatile("" ::: "memory");
    const int c = lane & 7;
#pragma unroll
    for (int j = 0; j < 4; ++j) { const int n = (lane >> 3) + 8 * j; const LAS float* s = scr + (8 * c) * 33 + n;
        v4u o; o.x = cvtpk_s(s[0 * 33], s[1 * 33]); o.y = cvtpk_s(s[2 * 33], s[3 * 33]); o.z = cvtpk_s(s[4 * 33], s[5 * 33]); o.w = cvtpk_s(s[6 * 33], s[7 * 33]);
        __builtin_nontemporal_store(o, (GAS v4u*)(WT + (size_t)(drow0 + n) * K + k0 + 8 * c)); }
    LDS_WAIT(); asm volatile("" ::: "memory");
}
__device__ __forceinline__ void tr_item8(const float* W, int K, int N, unsigned char* WT, int mode, const float* gk, float sc, LAS float* scr, int item, int lane) {
    const int nblk = N / 32, kb = item / nblk, nb = item % nblk, k0 = 128 * kb, n0 = 32 * nb;
    const int drow0 = (mode == 0) ? n0 : ((n0 >> 7) * 256 + (n0 & 127) + (mode == 2 ? 128 : 0));
#pragma unroll
    for (int h = 0; h < 2; ++h) { f32x4 w[8];
#pragma unroll
      for (int i = 0; i < 8; ++i) w[i] = __builtin_nontemporal_load((const GAS f32x4*)(W + (size_t)(k0 + 64 * h + 8 * i + (lane >> 3)) * N + n0 + 4 * (lane & 7)));
#pragma unroll
      for (int i = 0; i < 8; ++i) { const int r = 64 * h + 8 * i + (lane >> 3); const float gg = gk ? gk[k0 + r] * sc : sc; LAS float* d = scr + r * 33 + 4 * (4 * h + (i >> 1)) + 4 * (lane & 7);
          d[0] = w[i].x * gg; d[1] = w[i].y * gg; d[2] = w[i].z * gg; d[3] = w[i].w * gg; } }
    LDS_WAIT(); asm volatile("" ::: "memory");
    const int c = lane & 7;
#pragma unroll
    for (int j = 0; j < 4; ++j) { const int n = (lane >> 3) + 8 * j; const LAS float* s = scr + (16 * c) * 33 + 4 * c + n;
        v4u o; o.x = pg8::pk4_e4m3(s[0 * 33], s[1 * 33], s[2 * 33], s[3 * 33]); o.y = pg8::pk4_e4m3(s[4 * 33], s[5 * 33], s[6 * 33], s[7 * 33]);
        o.z = pg8::pk4_e4m3(s[8 * 33], s[9 * 33], s[10 * 33], s[11 * 33]); o.w = pg8::pk4_e4m3(s[12 * 33], s[13 * 33], s[14 * 33], s[15 * 33]);
        __builtin_nontemporal_store(o, (GAS v4u*)(WT + (size_t)(drow0 + n) * K + k0 + 16 * c)); }
    LDS_WAIT(); asm volatile("" ::: "memory");
}
__device__ __forceinline__ void rms_row_to_bf16(const float* xrow, const float* g, bf16* orow, int lane) {
    const GAS f32x4* xr = (const GAS f32x4*)xrow + lane; const GAS f32x4* gr = (const GAS f32x4*)g + lane;
    f32x4 v[4]; float s = 0.f;
#pragma unroll
    for (int j = 0; j < 4; ++j) { v[j] = xr[64 * j]; s += (v[j].x * v[j].x + v[j].y * v[j].y) + (v[j].z * v[j].z + v[j].w * v[j].w); }
    const float r = 1.0f / sqrtf(wave_sum(s) * (1.f / DM) + RMS_EPS);
    GAS unsigned long long* o8 = (GAS unsigned long long*)orow + lane;
#pragma unroll
    for (int j = 0; j < 4; ++j) { const f32x4 gg = gr[64 * j]; const f32x4 o = v[j] * r * gg;
        o8[64 * j] = (unsigned long long)pk2(o.x, o.y) | ((unsigned long long)pk2(o.z, o.w) << 32); }
}
constexpr bool GU8 = true, DN8 = true;
constexpr float SC_X1 = 16.f, SC_WGU = 128.f, SC_HID = 8.f, SC_WDN = 256.f, SC_Y = 64.f;
constexpr bool Y8 = true;
constexpr int CSCR_BYTES = 17408;
constexpr int CV_IN = 16 * 80, CV_KV = 16 * 16, CV_OUT = 16 * 32, CV_SMALL = CV_IN + CV_KV + CV_OUT, CV_GU = GU8 ? 512 : 1024, CV_DN = DN8 ? 512 : 1024, CV_LE = 2 * CV_GU + CV_DN, NITEMS = 2 * CV_SMALL + 2 * NE * CV_LE;
constexpr int DEFER_PER = GU8 ? 4 : 8;
constexpr int DEFER_WG0 = 160, N_DEFER0 = (256 - DEFER_WG0) * NWAVES * DEFER_PER;
constexpr int DEFER_WG1 = 128, N_DEFER1 = (256 - DEFER_WG1) * NWAVES * DEFER_PER;
constexpr int ATT_TAIL = GU8 ? 2 : 3, N_ATTT = 128 * NWAVES * ATT_TAIL;
constexpr int N_DEFER = N_DEFER0 + N_DEFER1 + 2 * N_ATTT;
__device__ __forceinline__ void conv_item(Frame& F, int it, LAS float* scr) {
    if (it < 2 * CV_SMALL) {
        const int l = it / CV_SMALL; int r = it % CV_SMALL;
        if (r < CV_IN) { tr_item(F.w_in + (size_t)l * DM * INW, DM, INW, F.WIN + (size_t)l * INW * DM, 0, F.norm_mix + (size_t)l * DM, scr, r, F.lane); return; } r -= CV_IN;
        if (r < CV_KV) { tr_item(F.w_mem_kv + (size_t)l * DM * 512, DM, 512, F.WKV + (size_t)l * 512 * DM, 0, nullptr, scr, r, F.lane); return; } r -= CV_KV;
        tr_item(F.w_out + (size_t)l * DM * DM, DM, DM, F.WOUT + (size_t)l * DM * DM, 0, nullptr, scr, r, F.lane);
    } else {
        const int r = it - 2 * CV_SMALL; const int le = r / CV_LE, q = r % CV_LE;
        if (q < 2 * CV_GU) { const int up = q >= CV_GU, item = q - up * CV_GU; const float* W = (up ? F.w_up : F.w_gate) + (size_t)le * DM * FF; const float* gk = F.norm_ffn + (size_t)(le / NE) * DM;
            if (GU8) tr_item8(W, DM, FF, (unsigned char*)F.WGU + (size_t)le * 2 * FF * DM, 1 + up, gk, SC_WGU, scr, item, F.lane);
            else tr_item(W, DM, FF, F.WGU + (size_t)le * 2 * FF * DM, 1 + up, gk, scr, item, F.lane); }
        else { const int item = q - 2 * CV_GU;
            if (DN8) tr_item8(F.w_down + (size_t)le * FF * DM, FF, DM, (unsigned char*)F.WDN + (size_t)le * DM * FF, 0, nullptr, SC_WDN, scr, item, F.lane);
            else tr_item(F.w_down + (size_t)le * FF * DM, FF, DM, F.WDN + (size_t)le * DM * FF, 0, nullptr, scr, item, F.lane); }
    }
}
__device__ __forceinline__ void p0_prologue(Frame& F, int part) {
    LAS float* scr = (LAS float*)(F.lds + F.wave * CSCR_BYTES);
    const int gw = F.vcu * NWAVES + F.wave, NGW = F.G * NWAVES;
    if (part == 1) { for (int it = 2 * CV_SMALL + gw; it < NITEMS - N_DEFER; it += NGW) conv_item(F, it, scr); return; }
    for (int it = gw; it < 2 * CV_SMALL; it += NGW) conv_item(F, it, scr);
    for (int m = gw; m < NB * MEMT; m += NGW) rms_row_to_bf16(F.mem + (size_t)m * DM, F.mem_norm, F.MEMN + (size_t)m * DM, F.lane);
    for (int m = gw; m < T; m += NGW) {
        const GAS f32x4* xr = (const GAS f32x4*)(F.x + (size_t)m * DM) + F.lane; f32x4 v[4]; float ss = 0.f;
#pragma unroll
        for (int j = 0; j < 4; ++j) { v[j] = __builtin_nontemporal_load(xr + 64 * j); ss += (v[j].x * v[j].x + v[j].y * v[j].y) + (v[j].z * v[j].z + v[j].w * v[j].w); }
        GAS unsigned long long* o8 = (GAS unsigned long long*)(F.XB + (size_t)m * DM) + F.lane;
#pragma unroll
        for (int j = 0; j < 4; ++j) o8[64 * j] = (unsigned long long)pk2(v[j].x, v[j].y) | ((unsigned long long)pk2(v[j].z, v[j].w) << 32);
        const float r = 1.0f / sqrtf(wave_sum(ss) * (1.f / DM) + RMS_EPS);
        if (F.lane == 0) F.RS0[m] = r;
    }
}

__device__ __forceinline__ s16x4 vtr(LAS unsigned char* p) { typedef short v4i16_t __attribute__((ext_vector_type(4))); return __builtin_bit_cast(s16x4, __builtin_amdgcn_ds_read_tr16_b64_v4i16((LAS v4i16_t*)p)); }
constexpr int KROW = 144;
constexpr int VROW = 192;
template <bool DIL>
__device__ __forceinline__ void attn_item(const bf16* qp, long q_rs, const bf16* kp, const bf16* vp, long kv_rs, int t_lo, int t_hi, int nt_total, float c2,
                                          bf16* op, long o_rs, float* lsep, long lse_rs, LAS unsigned char* kbuf, LAS unsigned char* vbuf, int lane) {
    const int ql = lane & 31, hh = lane >> 5;
    bf16x8 qf[4];
#pragma unroll
    for (int s = 0; s < 4; ++s) qf[s] = *(const GAS bf16x8*)(qp + (long)ql * q_rs + 16 * s + 8 * hh);
    f32x16 o0, o1;
#pragma unroll
    for (int i = 0; i < 16; ++i) { o0[i] = 0.f; o1[i] = 0.f; }
    float m_run = -INFINITY, l_run = 0.f;
    const float c1 = 0.125f * LOG2E;
    const float relbase = (float)(4 * hh - ql - 64);
    const int vq = (lane & 15) >> 2;
    LAS unsigned char* vrd = vbuf + (4 * hh + vq) * VROW + ((lane >> 4) & 1) * 32 + 8 * (lane & 3);
    LAS unsigned char* vwr = vbuf + (lane >> 3) * VROW + (lane & 7) * 16;
    LAS unsigned char* kwr = kbuf + (lane >> 3) * KROW + (lane & 7) * 16;
    LAS unsigned char* krd = kbuf + ql * KROW + 16 * hh;
    const bf16* krow = kp + (long)(32 * t_lo + (lane >> 3)) * kv_rs + 8 * (lane & 7);
    const bf16* vrow = vp + (long)(32 * t_lo + (lane >> 3)) * kv_rs + 8 * (lane & 7);
    v4u kk[4], vv[4];
#pragma unroll
    for (int i4 = 0; i4 < 4; ++i4) kk[i4] = *(const GAS v4u*)(krow + (long)(8 * i4) * kv_rs);
#pragma unroll
    for (int i4 = 0; i4 < 4; ++i4) vv[i4] = *(const GAS v4u*)(vrow + (long)(8 * i4) * kv_rs);
#pragma unroll 1
    for (int TI = t_lo; TI < t_hi; ++TI) {
        krow += 32 * kv_rs; vrow += 32 * kv_rs;
#pragma unroll
        for (int i4 = 0; i4 < 4; ++i4) *(LAS v4u*)(kwr + 8 * i4 * KROW) = kk[i4];
#pragma unroll
        for (int i4 = 0; i4 < 4; ++i4) *(LAS v4u*)(vwr + 8 * i4 * VROW) = vv[i4];
        if (TI + 1 < t_hi) {
#pragma unroll
            for (int i4 = 0; i4 < 4; ++i4) kk[i4] = *(const GAS v4u*)(krow + (long)(8 * i4) * kv_rs);
#pragma unroll
            for (int i4 = 0; i4 < 4; ++i4) vv[i4] = *(const GAS v4u*)(vrow + (long)(8 * i4) * kv_rs);
        }
        bf16x8 kf[4];
#pragma unroll
        for (int ss = 0; ss < 4; ++ss) kf[ss] = *(const LAS bf16x8*)(krd + 32 * ss);
        f32x16 acc;
#pragma unroll
        for (int i = 0; i < 16; ++i) acc[i] = 0.f;
#pragma unroll
        for (int ss = 0; ss < 4; ++ss) acc = __builtin_amdgcn_mfma_f32_32x32x16_bf16(kf[ss], qf[ss], acc, 0, 0, 0);
        if (DIL) {
            const float rb = relbase + (float)(32 * TI);
            const bool edge = (TI == 0) || (TI == nt_total - 1);
#pragma unroll
            for (int i = 0; i < 16; ++i) { const float ar = __builtin_fabsf(rb + (float)((i & 3) + 8 * (i >> 2))); float v = acc[i] * c1 - c2 * ar; if (edge) v = (ar > 64.f) ? -INFINITY : v; acc[i] = v; }
        } else {
#pragma unroll
            for (int i = 0; i < 16; ++i) acc[i] *= c1;
        }
        float mx = acc[0];
#pragma unroll
        for (int i = 1; i < 16; ++i) mx = __builtin_fmaxf(mx, acc[i]);
        mx = __builtin_fmaxf(mx, __shfl_xor(mx, 32));
        const float m_new = __builtin_fmaxf(m_run, mx);
        const float alpha = __builtin_amdgcn_exp2f(m_run - m_new);
        m_run = m_new;
        float ps = 0.f;
#pragma unroll
        for (int i = 0; i < 16; ++i) { acc[i] = __builtin_amdgcn_exp2f(acc[i] - m_new); ps += acc[i]; }
        l_run = l_run * alpha + ps;
#pragma unroll
        for (int i = 0; i < 16; ++i) { o0[i] *= alpha; o1[i] *= alpha; }
#pragma unroll
        for (int sk = 0; sk < 2; ++sk) {
            v4u pw; pw.x = cvtpk_s(acc[8 * sk + 0], acc[8 * sk + 1]); pw.y = cvtpk_s(acc[8 * sk + 2], acc[8 * sk + 3]);
            pw.z = cvtpk_s(acc[8 * sk + 4], acc[8 * sk + 5]); pw.w = cvtpk_s(acc[8 * sk + 6], acc[8 * sk + 7]);
            const bf16x8 pf = __builtin_bit_cast(bf16x8, pw);
            const s16x4 a0 = vtr(vrd + (16 * sk) * VROW), a1 = vtr(vrd + (16 * sk + 8) * VROW);
            const s16x4 b0 = vtr(vrd + (16 * sk) * VROW + 64), b1 = vtr(vrd + (16 * sk + 8) * VROW + 64);
            const bf16x8 vf0 = (bf16x8){a0[0], a0[1], a0[2], a0[3], a1[0], a1[1], a1[2], a1[3]};
            const bf16x8 vf1 = (bf16x8){b0[0], b0[1], b0[2], b0[3], b1[0], b1[1], b1[2], b1[3]};
            o0 = __builtin_amdgcn_mfma_f32_32x32x16_bf16(vf0, pf, o0, 0, 0, 0);
            o1 = __builtin_amdgcn_mfma_f32_32x32x16_bf16(vf1, pf, o1, 0, 0, 0);
        }
    }
    const float l_tot = l_run + __shfl_xor(l_run, 32);
    const float inv = 1.0f / l_tot;
    LAS unsigned char* ost = kbuf + ql * KROW + 8 * hh;
#pragma unroll
    for (int g4 = 0; g4 < 4; ++g4) {
        v2u w0, w1;
        w0.x = cvtpk_s(o0[4 * g4 + 0] * inv, o0[4 * g4 + 1] * inv); w0.y = cvtpk_s(o0[4 * g4 + 2] * inv, o0[4 * g4 + 3] * inv);
        w1.x = cvtpk_s(o1[4 * g4 + 0] * inv, o1[4 * g4 + 1] * inv); w1.y = cvtpk_s(o1[4 * g4 + 2] * inv, o1[4 * g4 + 3] * inv);
        *(LAS v2u*)(ost + 16 * g4) = w0; *(LAS v2u*)(ost + 64 + 16 * g4) = w1;
    }
    if (lsep != nullptr && hh == 0) lsep[(long)ql * lse_rs] = m_run + __builtin_log2f(l_tot);
#pragma unroll
    for (int i4 = 0; i4 < 4; ++i4) { const int row = (lane >> 3) + 8 * i4; const v4u w = *(const LAS v4u*)(kbuf + row * KROW + (lane & 7) * 16);
        *(GAS v4u*)(op + (long)row * o_rs + 8 * (lane & 7)) = w; }
}
__device__ __forceinline__ void p_attn_fast(Frame& F, int l) {
    LAS unsigned char* vbuf = F.lds + F.wave * 19200; LAS unsigned char* kbuf = vbuf + 6144;
    const int b = blockIdx.x % 8, widx = (blockIdx.x / 8) * NWAVES + F.wave, nw = (F.G / 8) * NWAVES;
    constexpr int NMEM = NMH * 64, NDIL = NDH * 3 * 64;
    for (int it = widx; it < NMEM + NDIL; it += nw) {
        if (it < NMEM) {
            const int hm = it / 64, blk = it % 64; const long row0 = (long)b * SEQ + 32 * blk;
            const bf16* kp = F.KVM + (size_t)(b * MEMT) * 1024 + 512 * l + 64 * hm;
            attn_item<false>(F.H + row0 * INW + C_QM + 64 * hm, INW, kp, kp + 256, 1024, 0, 8, 8, 0.f,
                                   F.MIX + row0 * DM + 768 + 64 * hm, DM, nullptr, 0, kbuf, vbuf, F.lane);
        } else {
            const int j = it - NMEM, h = j / 192, p = (j % 192) / 64, blk = j % 64;
            const int d = (p == 0) ? 1 : (p == 1 ? 4 : 16), L = SEQ / d, nb = L / 32, r = blk / nb, n = blk % nb;
            const long rowq = (long)b * SEQ + (long)(32 * n) * d + r, rowk = (long)b * SEQ + (long)(32 * n - 64) * d + r;
            const int t_lo = (n >= 2) ? 0 : 2 - n, t_hi = (n + 3 <= nb) ? 5 : nb + 2 - n;
            const float slope = __builtin_exp2f(-8.0f * (float)(h + 1) / (float)NDH);
            attn_item<true>(F.H + rowq * INW + C_Q + 64 * h, (long)d * INW, F.H + rowk * INW + C_K + 64 * h, F.H + rowk * INW + C_V + 64 * h, (long)d * INW, t_lo, t_hi, 5, slope * (float)d * LOG2E,
                                  F.OP + ((size_t)p * T + rowq) * 384 + 64 * h, (long)d * 384, F.LSE + ((size_t)p * T + rowq) * 6 + h, (long)d * 6, kbuf, vbuf, F.lane);
        }
    }
    if (widx >= 128 && SK(1)) {
        LAS float* cscr = (LAS float*)vbuf;
        const int first = NITEMS - N_DEFER + l * N_ATTT, w0 = b * 128 + (widx - 128);
        for (int j = 0; j < ATT_TAIL; ++j) conv_item(F, first + w0 + j * 1024, cscr);
    }
}

__device__ __forceinline__ void p_merge_conv(Frame& F, int l) {
    const int gw = F.vcu * NWAVES + F.wave, NGW = F.G * NWAVES;
    const float* cw = F.conv_w + (size_t)l * 3 * CONVC;
    for (int row = gw; row < T; row += NGW) {
        const int t = row % SEQ;
        if (F.lane < 48) {
            const int c0 = F.lane * 8;
            const bf16* hr = F.H + (size_t)row * INW;
            const v4u z = (v4u){0u, 0u, 0u, 0u};
            const v4u xm = (t > 0) ? *(const GAS v4u*)(hr - INW + C_XC + c0) : z, cm = (t > 0) ? *(const GAS v4u*)(hr - INW + C_CG + c0) : z;
            const v4u x0 = *(const GAS v4u*)(hr + C_XC + c0), cc = *(const GAS v4u*)(hr + C_CG + c0), bg = *(const GAS v4u*)(hr + C_BG + c0);
            const v4u xp = (t < SEQ - 1) ? *(const GAS v4u*)(hr + INW + C_XC + c0) : z, cp = (t < SEQ - 1) ? *(const GAS v4u*)(hr + INW + C_CG + c0) : z;
            float w0[8], w1[8], w2[8];
#pragma unroll
            for (int i = 0; i < 8; ++i) { w0[i] = cw[c0 + i]; w1[i] = cw[CONVC + c0 + i]; w2[i] = cw[2 * CONVC + c0 + i]; }
            v4u o;
#pragma unroll
            for (int i = 0; i < 4; ++i) {
                const float ulo = w0[2 * i] * (bflo(cm[i]) * bflo(xm[i])) + w1[2 * i] * (bflo(cc[i]) * bflo(x0[i])) + w2[2 * i] * (bflo(cp[i]) * bflo(xp[i]));
                const float uhi = w0[2 * i + 1] * (bfhi(cm[i]) * bfhi(xm[i])) + w1[2 * i + 1] * (bfhi(cc[i]) * bfhi(x0[i])) + w2[2 * i + 1] * (bfhi(cp[i]) * bfhi(xp[i]));
                o[i] = pk2(bflo(bg[i]) * ulo, bfhi(bg[i]) * uhi);
            }
            *(GAS v4u*)(F.MIX + (size_t)row * DM + c0) = o;
            const int h = F.lane >> 3;
            const float l0 = F.LSE[((size_t)0 * T + row) * 6 + h], l1 = F.LSE[((size_t)1 * T + row) * 6 + h], l2 = F.LSE[((size_t)2 * T + row) * 6 + h];
            const float mx = __builtin_fmaxf(l0, __builtin_fmaxf(l1, l2));
            float e0 = __builtin_amdgcn_exp2f(l0 - mx), e1 = __builtin_amdgcn_exp2f(l1 - mx), e2 = __builtin_amdgcn_exp2f(l2 - mx);
            const float inv = 1.0f / (e0 + e1 + e2); e0 *= inv; e1 *= inv; e2 *= inv;
            const v4u a0 = *(const GAS v4u*)(F.OP + ((size_t)0 * T + row) * 384 + c0), a1 = *(const GAS v4u*)(F.OP + ((size_t)1 * T + row) * 384 + c0), a2 = *(const GAS v4u*)(F.OP + ((size_t)2 * T + row) * 384 + c0);
            v4u od;
#pragma unroll
            for (int i = 0; i < 4; ++i) od[i] = pk2(e0 * bflo(a0[i]) + e1 * bflo(a1[i]) + e2 * bflo(a2[i]), e0 * bfhi(a0[i]) + e1 * bfhi(a1[i]) + e2 * bfhi(a2[i]));
            *(GAS v4u*)(F.MIX + (size_t)row * DM + 384 + c0) = od;
        }
    }
}

__device__ __forceinline__ void p_norm_router(Frame& F, int l) {
    LAS float* wl = (LAS float*)F.lds;
    const float* wr = F.w_router + (size_t)l * DM * NE;
    const float* g = F.norm_ffn + (size_t)l * DM;
    { f32x4 wv[8]; float gv[8];
#pragma unroll
      for (int k = 0; k < 8; ++k) { const int i4 = F.tid + 512 * k; wv[k] = *(const GAS f32x4*)(wr + 4 * i4); gv[k] = g[i4 >> 2]; }
#pragma unroll
      for (int k = 0; k < 8; ++k) { const int i4 = F.tid + 512 * k, d = i4 >> 2, e0 = (i4 & 3) * 4;
          wl[(e0 + 0) * DM + d] = wv[k].x * gv[k]; wl[(e0 + 1) * DM + d] = wv[k].y * gv[k]; wl[(e0 + 2) * DM + d] = wv[k].z * gv[k]; wl[(e0 + 3) * DM + d] = wv[k].w * gv[k]; } }
    __syncthreads();
    const int gw = F.vcu * NWAVES + F.wave, NGW = F.G * NWAVES;
    const bool b5 = (F.lane & 32) != 0, b4 = (F.lane & 16) != 0, b3 = (F.lane & 8) != 0, b2 = (F.lane & 4) != 0, b1 = (F.lane & 2) != 0;
    v2u vn[2][4];
    if (gw < T / 2) {
#pragma unroll
        for (int r = 0; r < 2; ++r) { const GAS v2u* xr = (const GAS v2u*)(F.X1B + (size_t)(2 * gw + r) * DM) + F.lane;
#pragma unroll
            for (int j = 0; j < 4; ++j) vn[r][j] = xr[64 * j]; }
    }
    for (int pr = gw; pr < T / 2; pr += NGW) {
        const int row0 = 2 * pr;
        f32x4 v[2][4];
#pragma unroll
        for (int r = 0; r < 2; ++r)
#pragma unroll
            for (int j = 0; j < 4; ++j) { v[r][j].x = bflo(vn[r][j].x); v[r][j].y = bfhi(vn[r][j].x); v[r][j].z = bflo(vn[r][j].y); v[r][j].w = bfhi(vn[r][j].y); }
        float ssum[2];
#pragma unroll
        for (int r = 0; r < 2; ++r) { const GAS f32x4* sp = (const GAS f32x4*)(F.SS1 + (size_t)(row0 + r) * 16); const f32x4 p0 = sp[0], p1 = sp[1], p2 = sp[2], p3 = sp[3];
            ssum[r] = ((((p0.x + p0.y) + (p0.z + p0.w)) + ((p1.x + p1.y) + (p1.z + p1.w))) + (((p2.x + p2.y) + (p2.z + p2.w)) + ((p3.x + p3.y) + (p3.z + p3.w)))); }
        const float r0 = 1.0f / sqrtf(ssum[0] * (1.f / DM) + RMS_EPS), r1 = 1.0f / sqrtf(ssum[1] * (1.f / DM) + RMS_EPS);
        if (pr + NGW < T / 2) {
#pragma unroll
            for (int r = 0; r < 2; ++r) { const GAS v2u* xr = (const GAS v2u*)(F.X1B + (size_t)(2 * (pr + NGW) + r) * DM) + F.lane;
#pragma unroll
                for (int j = 0; j < 4; ++j) vn[r][j] = xr[64 * j]; }
        }
        float lg[32];
        LAS float* wlp = wl + 4 * F.lane; asm volatile("" : "+v"(wlp));
#pragma unroll
        for (int e = 0; e < NE; ++e) { float a0 = 0.f, a1 = 0.f;
#pragma unroll
            for (int j = 0; j < 4; ++j) { const f32x4 w = *(const LAS f32x4*)(wlp + e * DM + 256 * j);
                a0 = __builtin_fmaf(v[0][j].x, w.x, a0); a0 = __builtin_fmaf(v[0][j].y, w.y, a0); a0 = __builtin_fmaf(v[0][j].z, w.z, a0); a0 = __builtin_fmaf(v[0][j].w, w.w, a0);
                a1 = __builtin_fmaf(v[1][j].x, w.x, a1); a1 = __builtin_fmaf(v[1][j].y, w.y, a1); a1 = __builtin_fmaf(v[1][j].z, w.z, a1); a1 = __builtin_fmaf(v[1][j].w, w.w, a1); }
            asm volatile("" : "+v"(wlp), "+v"(a0), "+v"(a1)); lg[e] = a0; lg[16 + e] = a1; }
        if (F.lane == 0) { F.RS1[row0] = r0; F.RS1[row0 + 1] = r1; }
#pragma unroll
        for (int k = 0; k < 16; ++k) { const float keep = b5 ? lg[16 + k] : lg[k], send = b5 ? lg[k] : lg[16 + k]; lg[k] = keep + __shfl_xor(send, 32); }
#pragma unroll
        for (int k = 0; k < 8; ++k) { const float keep = b4 ? lg[8 + k] : lg[k], send = b4 ? lg[k] : lg[8 + k]; lg[k] = keep + __shfl_xor(send, 16); }
#pragma unroll
        for (int k = 0; k < 4; ++k) { const float keep = b3 ? lg[4 + k] : lg[k], send = b3 ? lg[k] : lg[4 + k]; lg[k] = keep + __shfl_xor(send, 8); }
#pragma unroll
        for (int k = 0; k < 2; ++k) { const float keep = b2 ? lg[2 + k] : lg[k], send = b2 ? lg[k] : lg[2 + k]; lg[k] = keep + __shfl_xor(send, 4); }
        { const float keep = b1 ? lg[1] : lg[0], send = b1 ? lg[0] : lg[1]; lg[0] = keep + __shfl_xor(send, 2); }
        float lgt = (lg[0] + __shfl_xor(lg[0], 1)) * (b5 ? r1 : r0);
        float mx = lgt;
#pragma unroll
        for (int m = 2; m <= 16; m <<= 1) mx = __builtin_fmaxf(mx, __shfl_xor(mx, m));
        const float ex = __expf(lgt - mx); float sum = ex;
#pragma unroll
        for (int m = 2; m <= 16; m <<= 1) sum += __shfl_xor(sum, m);
        const int e = (b4 ? 8 : 0) + (b3 ? 4 : 0) + (b2 ? 2 : 0) + (b1 ? 1 : 0);
        const int row = row0 + (b5 ? 1 : 0), bb = row / SEQ, t = row % SEQ;
        if ((F.lane & 1) == 0) F.AFFT[((size_t)bb * NE + e) * SEQ + t] = ex / sum;
    }
    __syncthreads();
}

constexpr int RW_RS = 2064;
__device__ __forceinline__ void p_router_mfma(Frame& F, int l) {
    LAS unsigned char* WH = F.lds; LAS unsigned char* WL = F.lds + 16 * RW_RS; LAS f32x4* XCH = (LAS f32x4*)(F.lds + 32 * RW_RS);
    const float* wr = F.w_router + (size_t)l * DM * NE;
    const float* g = F.norm_ffn + (size_t)l * DM;
    { f32x4 wa[4], wb[4]; float ga[4], gb[4];
#pragma unroll
      for (int k = 0; k < 4; ++k) { const int c = F.tid + 512 * k, dp = c >> 2, e0 = (c & 3) * 4;
          wa[k] = *(const GAS f32x4*)(wr + (size_t)(2 * dp) * NE + e0); wb[k] = *(const GAS f32x4*)(wr + (size_t)(2 * dp + 1) * NE + e0); ga[k] = g[2 * dp]; gb[k] = g[2 * dp + 1]; }
#pragma unroll
      for (int k = 0; k < 4; ++k) { const int c = F.tid + 512 * k, dp = c >> 2, e0 = (c & 3) * 4;
#pragma unroll
          for (int j = 0; j < 4; ++j) { const float va = wa[k][j] * ga[k], vb = wb[k][j] * gb[k];
              const unsigned ha = f2bf(va), hb = f2bf(vb);
              const float ra = va - __builtin_bit_cast(float, ha << 16), rb = vb - __builtin_bit_cast(float, hb << 16);
              *(LAS unsigned*)(WH + (e0 + j) * RW_RS + 4 * dp) = ha | (hb << 16);
              *(LAS unsigned*)(WL + (e0 + j) * RW_RS + 4 * dp) = f2bf(ra) | (f2bf(rb) << 16); } } }
    __syncthreads();
    int tid_ = F.tid; asm volatile("" : "+v"(tid_));
    const int lane = tid_ & 63, tile = F.wave >> 1, kh = F.wave & 1, r16 = lane & 15, kq = lane >> 4;
    for (int blk = F.vcu; blk < T / 64; blk += F.G) {
        const int row0 = blk * 64 + tile * 16;
        const bf16* xr = F.X1B + (size_t)(row0 + r16) * DM + 512 * kh + 8 * kq;
        bf16x8 af[16];
#pragma unroll
        for (int s_ = 0; s_ < 16; ++s_) af[s_] = *(const GAS bf16x8*)(xr + 32 * s_);
        float rsum; { const f32x4 pp = *(const GAS f32x4*)(F.SS1 + (size_t)(row0 + (lane >> 2)) * 16 + 4 * (lane & 3)); rsum = (pp.x + pp.y) + (pp.z + pp.w); }
        rsum += __shfl_xor(rsum, 1); rsum += __shfl_xor(rsum, 2);
        const float rrow = 1.0f / sqrtf(rsum * (1.f / DM) + RMS_EPS);
        f32x4 acc = (f32x4){0.f, 0.f, 0.f, 0.f};
        const LAS unsigned char* bh = WH + r16 * RW_RS + (512 * kh + 8 * kq) * 2; const LAS unsigned char* bl = WL + r16 * RW_RS + (512 * kh + 8 * kq) * 2;
#pragma unroll
        for (int s_ = 0; s_ < 16; ++s_) {
            const bf16x8 fh = *(const LAS bf16x8*)(bh + 64 * s_), fl = *(const LAS bf16x8*)(bl + 64 * s_);
            acc = __builtin_amdgcn_mfma_f32_16x16x32_bf16(af[s_], fh, acc, 0, 0, 0);
            acc = __builtin_amdgcn_mfma_f32_16x16x32_bf16(af[s_], fl, acc, 0, 0, 0);
        }
        if (kh == 1) XCH[tile * 64 + lane] = acc;
        __syncthreads();
        if (kh == 0) {
            acc = acc + XCH[tile * 64 + lane];
            float rs4[4];
#pragma unroll
            for (int j = 0; j < 4; ++j) rs4[j] = __shfl(rrow, 4 * (4 * kq + j));
            f32x4 aff;
#pragma unroll
            for (int j = 0; j < 4; ++j) {
                const float lg = acc[j] * rs4[j];
                float mx = lg;
#pragma unroll
                for (int m = 1; m <= 8; m <<= 1) mx = __builtin_fmaxf(mx, __shfl_xor(mx, m));
                const float ex = __expf(lg - mx); float sm = ex;
#pragma unroll
                for (int m = 1; m <= 8; m <<= 1) sm += __shfl_xor(sm, m);
                aff[j] = ex / sm;
            }
            const int rowa = row0 + 4 * kq, bb = rowa / SEQ, t = rowa % SEQ;
            *(GAS f32x4*)(F.AFFT + ((size_t)bb * NE + r16) * SEQ + t) = aff;
            if (r16 == 0) *(GAS f32x4*)(F.RS1 + rowa) = (f32x4){rs4[0], rs4[1], rs4[2], rs4[3]};
        }
        __syncthreads();
    }
}

__device__ __forceinline__ void p_topk_pair(Frame& F, int b, int e, LAS int* lidx, LAS float* lrs, bool writer) {
    LAS unsigned* cnt = (LAS unsigned*)F.lds;
    LAS unsigned* tab = (LAS unsigned*)(F.lds + 256);
    {
        const float* src = F.AFFT + (size_t)(b * NE + e) * SEQ;
        unsigned x[4];
#pragma unroll
        for (int i = 0; i < 4; ++i) x[i] = __builtin_bit_cast(unsigned, src[i * 512 + F.tid]);
        float rs1v[4];
#pragma unroll
        for (int i = 0; i < 4; ++i) rs1v[i] = F.RS1[(size_t)b * SEQ + i * 512 + F.tid];
        unsigned prefix = 0u;
#pragma unroll 1
        for (int ps = 0; ps < 16; ++ps) {
            const int sh = 30 - 2 * ps;
            const unsigned c1 = prefix | (1u << sh), c2 = prefix | (2u << sh), c3 = prefix | (3u << sh);
            unsigned n1 = 0u, n2 = 0u, n3 = 0u;
#pragma unroll
            for (int i = 0; i < 4; ++i) { n1 += (unsigned)__builtin_popcountll(__ballot(x[i] >= c1)); n2 += (unsigned)__builtin_popcountll(__ballot(x[i] >= c2)); n3 += (unsigned)__builtin_popcountll(__ballot(x[i] >= c3)); }
            const int par = (ps & 1) * 24;
            if (F.lane == 0) { cnt[par + F.wave] = n1; cnt[par + 8 + F.wave] = n2; cnt[par + 16 + F.wave] = n3; }
            __syncthreads();
            unsigned t1 = 0u, t2 = 0u, t3 = 0u;
#pragma unroll
            for (int w = 0; w < 8; ++w) { t1 += cnt[par + w]; t2 += cnt[par + 8 + w]; t3 += cnt[par + 16 + w]; }
            if (t3 >= (unsigned)CAP) prefix = c3; else if (t2 >= (unsigned)CAP) prefix = c2; else if (t1 >= (unsigned)CAP) prefix = c1;
        }
        unsigned long long bq[4], bs[4];
#pragma unroll
        for (int i = 0; i < 4; ++i) { const unsigned long long bg = __ballot(x[i] > prefix); bq[i] = __ballot(x[i] == prefix);
            if (F.lane == 0) { tab[i * 8 + F.wave] = (unsigned)__builtin_popcountll(bg); tab[32 + i * 8 + F.wave] = (unsigned)__builtin_popcountll(bq[i]); } }
        __syncthreads();
        unsigned gtot = 0u;
#pragma unroll
        for (int j = 0; j < 32; ++j) gtot += tab[j];
        const unsigned need = (unsigned)CAP - gtot;
        unsigned run = 0u, eqb[4];
#pragma unroll
        for (int j = 0; j < 32; ++j) { const unsigned v = tab[32 + j];
#pragma unroll
            for (int i = 0; i < 4; ++i) if (j == i * 8 + F.wave) eqb[i] = run;
            run += v; }
        bool sel[4];
#pragma unroll
        for (int i = 0; i < 4; ++i) {
            const unsigned rk = eqb[i] + __builtin_amdgcn_mbcnt_hi((unsigned)(bq[i] >> 32), __builtin_amdgcn_mbcnt_lo((unsigned)bq[i], 0u));
            sel[i] = (x[i] > prefix) || (x[i] == prefix && rk < need);
            bs[i] = __ballot(sel[i]);
            if (F.lane == 0) tab[64 + i * 8 + F.wave] = (unsigned)__builtin_popcountll(bs[i]);
        }
        __syncthreads();
        run = 0u; unsigned selb[4];
#pragma unroll
        for (int j = 0; j < 32; ++j) { const unsigned v = tab[64 + j];
#pragma unroll
            for (int i = 0; i < 4; ++i) if (j == i * 8 + F.wave) selb[i] = run;
            run += v; }
#pragma unroll
        for (int i = 0; i < 4; ++i) {
            const int t = i * 512 + F.tid, row = b * SEQ + t;
            const unsigned slot = selb[i] + __builtin_amdgcn_mbcnt_hi((unsigned)(bs[i] >> 32), __builtin_amdgcn_mbcnt_lo((unsigned)bs[i], 0u));
            if (sel[i]) { lidx[slot] = row; lrs[slot] = rs1v[i] * (GU8 ? 1.f / (SC_X1 * SC_WGU) : 1.f); if (writer) F.GROW[(size_t)e * ER + b * CAP + slot] = __builtin_bit_cast(float, x[i]) * ((DN8 ? 1.f / (SC_HID * SC_WDN) : 1.f) * (Y8 ? SC_Y : 1.f)); }
            if (writer) F.INV[(size_t)row * NE + e] = (short)(sel[i] ? (int)slot : -1);
        }
        __syncthreads();
    }
}

template <bool YF8>
__device__ __forceinline__ void p_combine_norm(Frame& F, int l) {
    const int gw = F.vcu * NWAVES + F.wave, NGW = F.G * NWAVES;
    const bf16* Y = F.XG;
    const GAS f32x4* gr = (const GAS f32x4*)F.norm_final + F.lane;
    for (int pr = gw; pr < T / 2; pr += NGW) {
        typedef float f32x2 __attribute__((ext_vector_type(2)));
        v2u xv[2][4]; typename std::conditional<YF8, unsigned, v2u>::type yv[2][4][4]; float ysc[2][4]; unsigned rest[2]; int invr[2];
#pragma unroll
        for (int q = 0; q < 2; ++q) {
            const int row = pr + q * (T / 2), b = row / SEQ;
            const GAS v2u* xr = (const GAS v2u*)(F.X1B + (size_t)row * DM) + F.lane;
#pragma unroll
            for (int j = 0; j < 4; ++j) xv[q][j] = xr[64 * j];
            invr[q] = (int)F.INV[(size_t)row * NE + (F.lane & 15)];
            unsigned m = (unsigned)__ballot(invr[q] >= 0) & 0xffffu;
#pragma unroll
            for (int k = 0; k < 4; ++k) {
                const bool has = m != 0u; const int e = has ? __builtin_ctz(m) : 0; m &= m - 1u;
                const int r = has ? __builtin_amdgcn_readlane(invr[q], e) : 0;
                ysc[q][k] = has ? (YF8 ? 1.f / SC_Y : 1.f) : 0.f;
                if constexpr (YF8) { const GAS unsigned* yr = (const GAS unsigned*)((const unsigned char*)Y + ((size_t)e * ER + b * CAP + r) * DM) + F.lane;
#pragma unroll
                    for (int j = 0; j < 4; ++j) yv[q][k][j] = yr[64 * j]; }
                else { const GAS v2u* yr = (const GAS v2u*)(Y + ((size_t)e * ER + b * CAP + r) * DM) + F.lane;
#pragma unroll
                    for (int j = 0; j < 4; ++j) yv[q][k][j] = yr[64 * j]; }
            }
            rest[q] = m;
        }
#pragma unroll
        for (int q = 0; q < 2; ++q) {
            const int row = pr + q * (T / 2), b = row / SEQ;
            f32x4 v[4];
#pragma unroll
            for (int j = 0; j < 4; ++j) { v[j].x = bflo(xv[q][j].x); v[j].y = bfhi(xv[q][j].x); v[j].z = bflo(xv[q][j].y); v[j].w = bfhi(xv[q][j].y); }
#pragma unroll
            for (int k = 0; k < 4; ++k)
#pragma unroll
                for (int j = 0; j < 4; ++j) { const float sc = ysc[q][k];
                    if constexpr (YF8) { const unsigned w = yv[q][k][j]; const f32x2 lo = __builtin_amdgcn_cvt_pk_f32_fp8((int)w, false), hi = __builtin_amdgcn_cvt_pk_f32_fp8((int)w, true);
                        v[j].x += sc * lo.x; v[j].y += sc * lo.y; v[j].z += sc * hi.x; v[j].w += sc * hi.y; }
                    else { const v2u w = yv[q][k][j]; v[j].x += sc * bflo(w.x); v[j].y += sc * bfhi(w.x); v[j].z += sc * bflo(w.y); v[j].w += sc * bfhi(w.y); } }
            unsigned m = rest[q];
            while (m != 0u) {
                const int e = __builtin_ctz(m); m &= m - 1u; const int r = __builtin_amdgcn_readlane(invr[q], e);
                if constexpr (YF8) { const GAS unsigned* yr = (const GAS unsigned*)((const unsigned char*)Y + ((size_t)e * ER + b * CAP + r) * DM) + F.lane;
#pragma unroll
                    for (int j = 0; j < 4; ++j) { const unsigned w = yr[64 * j]; const f32x2 lo = __builtin_amdgcn_cvt_pk_f32_fp8((int)w, false), hi = __builtin_amdgcn_cvt_pk_f32_fp8((int)w, true);
                        v[j].x += (1.f / SC_Y) * lo.x; v[j].y += (1.f / SC_Y) * lo.y; v[j].z += (1.f / SC_Y) * hi.x; v[j].w += (1.f / SC_Y) * hi.y; } }
                else { const GAS v2u* yr = (const GAS v2u*)(Y + ((size_t)e * ER + b * CAP + r) * DM) + F.lane;
#pragma unroll
                for (int j = 0; j < 4; ++j) { const v2u w = yr[64 * j]; v[j].x += bflo(w.x); v[j].y += bfhi(w.x); v[j].z += bflo(w.y); v[j].w += bfhi(w.y); } }
            }
            float s = 0.f;
#pragma unroll
            for (int j = 0; j < 4; ++j) s += (v[j].x * v[j].x + v[j].y * v[j].y) + (v[j].z * v[j].z + v[j].w * v[j].w);
            const float rr = 1.0f / sqrtf(wave_sum(s) * (1.f / DM) + RMS_EPS);
            if (l + 1 < NLAYER) {
                GAS unsigned long long* o8 = (GAS unsigned long long*)(F.XB + (size_t)row * DM) + F.lane;
#pragma unroll
                for (int j = 0; j < 4; ++j) o8[64 * j] = (unsigned long long)pk2(v[j].x, v[j].y) | ((unsigned long long)pk2(v[j].z, v[j].w) << 32);
                if (F.lane == 0) F.RS0[row] = rr;
            } else {
                GAS f32x4* orow = (GAS f32x4*)(F.out + (size_t)row * DM) + F.lane;
#pragma unroll
                for (int j = 0; j < 4; ++j) __builtin_nontemporal_store(v[j] * rr * gr[64 * j], orow + 64 * j);
            }
        }
    }
}

struct Args { const float* in[14]; float* out; unsigned char* ws; int ph_lo, ph_hi, li, pad; };
constexpr int NPHASE = 1 + 9 * NLAYER;
template <class Tp> __device__ __forceinline__ Tp* as_global(Tp* p) { return (Tp*)(GAS Tp*)p; }
__device__ __forceinline__ void build_frame(Frame& F) {
    extern __shared__ __attribute__((aligned(16))) unsigned char lds[];
    const CAS Args* A = (const CAS Args*)__builtin_amdgcn_kernarg_segment_ptr();
    asm volatile("" : "+s"(A));
    int tid = threadIdx.x; asm volatile("" : "+v"(tid));
    F.lds = (LAS unsigned char*)lds;
    F.tid = tid; F.lane = tid & 63; F.wave = __builtin_amdgcn_readfirstlane(tid >> 6);
    F.G = gridDim.x; { const int bx = blockIdx.x; F.vcu = (F.G % 8 == 0) ? (bx % 8) * (F.G / 8) + bx / 8 : bx; }
    unsigned char* ws = as_global(A->ws);
    F.x = as_global(A->in[0]); F.mem = as_global(A->in[1]); F.mem_norm = as_global(A->in[2]); F.norm_mix = as_global(A->in[3]); F.w_in = as_global(A->in[4]); F.conv_w = as_global(A->in[5]); F.w_mem_kv = as_global(A->in[6]);
    F.w_out = as_global(A->in[7]); F.norm_ffn = as_global(A->in[8]); F.w_router = as_global(A->in[9]); F.w_gate = as_global(A->in[10]); F.w_up = as_global(A->in[11]); F.w_down = as_global(A->in[12]); F.norm_final = as_global(A->in[13]);
    F.out = as_global(A->out);
    F.WIN = (bf16*)(ws + WS_WIN); F.WKV = (bf16*)(ws + WS_WKV); F.WOUT = (bf16*)(ws + WS_WOUT); F.WGU = (bf16*)(ws + WS_WGU); F.WDN = (bf16*)(ws + WS_WDN);
    F.XB = (bf16*)(ws + WS_XB); F.X1B = (bf16*)(ws + WS_X1B); F.H = (bf16*)(ws + WS_H); F.OP = (bf16*)(ws + WS_OP); F.MIX = (bf16*)(ws + WS_MIX); F.MEMN = (bf16*)(ws + WS_MEMN); F.KVM = (bf16*)(ws + WS_KVM);
    F.XG = (bf16*)(ws + WS_XG); F.HID = (bf16*)(ws + WS_HID); F.LSE = (float*)(ws + WS_LSE); F.AFFT = (float*)(ws + WS_AFFT); F.GROW = (float*)(ws + WS_GROW); F.INV = (short*)(ws + WS_INV); F.IDX = (int*)(ws + WS_IDX); F.RS0 = (float*)(ws + WS_RS0); F.SS1 = (float*)(ws + WS_SS1); F.RS1 = (float*)(ws + WS_RS1); F.RSLOT = (float*)(ws + WS_RSLOT); F.X1F8 = ws + WS_X1F8;
}
__device__ __forceinline__ void seam_barrier() {
    extern __shared__ __attribute__((aligned(16))) unsigned char lds[];
    const CAS Args* A = (const CAS Args*)__builtin_amdgcn_kernarg_segment_ptr();
    asm volatile("" : "+s"(A));
    XcdBarrier b;
#if ONE_LAUNCH
    b.bar = as_global((unsigned*)g_barrier_words);
#else
    b.bar = (unsigned*)(as_global(A->ws) + WS_CTL) + CW_BAR + A->li * XCD_BAR_WORDS;
#endif
    b.x = xb_xcc_id(); b.st = (volatile LAS unsigned*)((LAS unsigned char*)lds + MISC_OFF) + 8;
    xcd_barrier(b);
}
__global__ void __launch_bounds__(NWAVES * 64, 2) mega_fwd(Args args) {
    extern __shared__ __attribute__((aligned(16))) unsigned char lds[];
    for (int u = threadIdx.x; u < (LDS_BYTES - LDSCTL_OFF) / 4; u += NWAVES * 64) ((LAS unsigned*)((LAS unsigned char*)lds + LDSCTL_OFF))[u] = 0u;
    __syncthreads();
    const int lo = args.ph_lo, hi = args.ph_hi;
#if ONE_LAUNCH
    if (hi - lo > 1) (void)xcd_barrier_post(as_global((unsigned*)g_barrier_words), (volatile LAS unsigned*)((LAS unsigned char*)lds + MISC_OFF) + 8);
#else
    if (hi - lo > 1) (void)xcd_barrier_post((unsigned*)(args.ws + WS_CTL) + CW_BAR + args.li * XCD_BAR_WORDS, (volatile LAS unsigned*)((LAS unsigned char*)lds + MISC_OFF) + 8);
#endif
#define IN(k) (lo <= (k) && (k) < hi)
#define SEAM(k) do { if ((k) + 1 < hi) for (int rep = 0; rep < NREP(2048); ++rep) seam_barrier(); } while (0)

    if (IN(0)) { if (SK(1)) for (int rep = 0; rep < NREP(1); ++rep) { Frame F; build_frame(F); p0_prologue(F, 0); } SEAM(0);
                 if (SK(1)) for (int rep = 0; rep < NREP(1); ++rep) { Frame F; build_frame(F); p0_prologue(F, 1); } __syncthreads(); }
#pragma unroll 1
    for (int l = 0; l < NLAYER; ++l) {
        const int pb = 1 + 9 * l;
        if (IN(pb + 0)) {
            if (SK(2)) for (int rep = 0; rep < NREP(2); ++rep) { Frame F; build_frame(F);
              pg8::Gemm g{F.XB, F.WIN + (size_t)l * INW * DM, T, INW, DM, 1 << 30, 0, nullptr}; pg8::StaticOrder S; S.init(T, INW, F.G, (int)blockIdx.x);
              pg8::EpiBf16 E{F.H, INW, F.RS0};
              pg8::gemm_phase<pg8::EpiBf16, pg8::StaticOrder, true, true>(F.lds, g, S, E); }
            if (SK(4) && l == 0) { Frame F; build_frame(F);
              pg8::Gemm g{F.MEMN, F.WKV, NB * MEMT, 1024, DM, 1 << 30, 0, nullptr}; pg8::StaticOrder S; S.init(NB * MEMT, 1024, F.G, (int)((blockIdx.x + F.G / 2) % F.G));
              pg8::EpiBf16 E{F.KVM, 1024, nullptr};
              pg8::gemm_phase<pg8::EpiBf16, pg8::StaticOrder, true, true>(F.lds, g, S, E); }
            { const int wg0 = (l == 0) ? DEFER_WG0 : DEFER_WG1, first = (l == 0) ? NITEMS - N_DEFER0 : NITEMS - N_DEFER0 - N_DEFER1;
              if (SK(1) && (int)blockIdx.x >= wg0) { Frame F; build_frame(F);
                LAS float* scr = (LAS float*)(F.lds + F.wave * CSCR_BYTES); const int w0 = ((int)blockIdx.x - wg0) * NWAVES + F.wave;
                for (int j = 0; j < DEFER_PER; ++j) conv_item(F, first + w0 + j * (256 - wg0) * NWAVES, scr); } }
            SEAM(pb + 0);
        }
        if (IN(pb + 1)) { if (SK(8)) for (int rep = 0; rep < NREP(8); ++rep) { Frame F; build_frame(F); p_attn_fast(F, l); } SEAM(pb + 1); }
        if (IN(pb + 2)) { if (SK(16)) for (int rep = 0; rep < NREP(16); ++rep) { Frame F; build_frame(F); p_merge_conv(F, l); } SEAM(pb + 2); }
        if (IN(pb + 3)) {
            if (SK(32)) for (int rep = 0; rep < NREP(32); ++rep) { Frame F; build_frame(F);
            pg8::Gemm g{F.MIX, F.WOUT + (size_t)l * DM * DM, T, DM, DM, 1 << 30, 0, nullptr}; pg8::StaticOrder S; S.init(T, DM, F.G, (int)blockIdx.x);
            pg8::EpiResBf16 E{F.XB, F.X1B, DM, F.SS1, GU8 ? F.X1F8 : nullptr, SC_X1};
            pg8::gemm_phase<pg8::EpiResBf16, pg8::StaticOrder, false, true>(F.lds, g, S, E); }
            SEAM(pb + 3);
        }
        if (IN(pb + 4)) { if (SK(64)) for (int rep = 0; rep < NREP(64); ++rep) { Frame F; build_frame(F); if (ROUTER_MFMA) p_router_mfma(F, l); else p_norm_router(F, l); } SEAM(pb + 4); }
        if (IN(pb + 6)) {
            if (SK(256)) for (int rep = 0; rep < NREP(256); ++rep) { Frame F; build_frame(F);
            const int e = F.vcu >> 4, b = F.vcu & 7, pm = e * 8 + b;
            LAS int* lidx = (LAS int*)(F.lds + LDSX_OFF); LAS float* lrs = (LAS float*)(F.lds + LDSX_OFF + 1024);
            p_topk_pair(F, b, e, lidx, lrs, ((F.vcu >> 3) & 1) == 0);
            pg8::ExpertOrder S; S.init(F.vcu);
            static_assert(GU8 == DN8, "expert GEMMs: both fp8 or both bf16");
            if constexpr (GU8) {
              pg8::Gemm g{(const pg8::bf16_t*)F.X1F8, (const pg8::bf16_t*)((const unsigned char*)F.WGU + (size_t)l * NE * 2 * FF * DM), NE * ER, 2 * FF, DM / 2, ER / 256, (size_t)2 * FF * DM / 2, (const int*)lidx - pm * 256};
              pg8::EpiSwiGLU8 E{(unsigned char*)F.HID, FF, (const float*)lrs - pm * 256, SC_HID};
              pg8::gemm_phase<pg8::EpiSwiGLU8, pg8::ExpertOrder, true, true, true, true>(F.lds, g, S, E); }
            else { pg8::Gemm g{F.X1B, F.WGU + (size_t)l * NE * 2 * FF * DM, NE * ER, 2 * FF, DM, ER / 256, (size_t)2 * FF * DM, (const int*)lidx - pm * 256};
              pg8::EpiSwiGLU E{F.HID, FF, (const float*)lrs - pm * 256};
              pg8::gemm_phase<pg8::EpiSwiGLU, pg8::ExpertOrder, true, true, true>(F.lds, g, S, E); } }
            SEAM(pb + 6);
        }
        if (IN(pb + 7)) {
            if (SK(512)) for (int rep = 0; rep < NREP(512); ++rep) { Frame F; build_frame(F);
            pg8::StaticOrder S; S.init(NE * ER, DM, F.G, (int)blockIdx.x); pg8::EpiBf16 E{F.XG, DM, F.GROW};
            static_assert(!Y8 || DN8, "fp8 Y needs the fp8 down projection");
            if constexpr (DN8) {
              pg8::Gemm g{F.HID, (const pg8::bf16_t*)((const unsigned char*)F.WDN + (size_t)l * NE * DM * FF), NE * ER, DM, FF / 2, ER / 256, (size_t)DM * FF / 2, nullptr};
              if constexpr (Y8) { pg8::EpiF8 E8{(unsigned char*)F.XG, DM, F.GROW}; pg8::gemm_phase<pg8::EpiF8, pg8::StaticOrder, true, true, false, true>(F.lds, g, S, E8); }
              else pg8::gemm_phase<pg8::EpiBf16, pg8::StaticOrder, true, true, false, true>(F.lds, g, S, E); }
            else { pg8::Gemm g{F.HID, F.WDN + (size_t)l * NE * DM * FF, NE * ER, DM, FF, ER / 256, (size_t)DM * FF, nullptr};
              pg8::gemm_phase<pg8::EpiBf16, pg8::StaticOrder, true, true>(F.lds, g, S, E); } }
            SEAM(pb + 7);
        }
        if (IN(pb + 8)) { if (SK(1024)) for (int rep = 0; rep < NREP(1024); ++rep) { Frame F; build_frame(F); p_combine_norm<Y8>(F, l); } SEAM(pb + 8); }
    }
#undef IN
#undef SEAM
#if ONE_LAUNCH
    if (hi - lo > 1) {
        __syncthreads();
        if (threadIdx.x == 0) { unsigned* bar = as_global((unsigned*)g_barrier_words);
            if (xb_add(&bar[XB_EXIT], 1u) + 1u == gridDim.x) {
                for (unsigned j = 0; j < 16; ++j) { __hip_atomic_store(&bar[XB_XCNT(j)], 0u, RLX_AGENT); __hip_atomic_store(&bar[XB_XSUB(j)], 0u, RLX_AGENT); __hip_atomic_store(&bar[XB_XGEN(j)], 0u, RLX_AGENT); }
                __hip_atomic_store(&bar[XB_TOP], 0u, RLX_AGENT); __hip_atomic_store(&bar[XB_TOPGEN], 0u, RLX_AGENT); __hip_atomic_store(&bar[XB_TMO], 0u, RLX_AGENT); __hip_atomic_store(&bar[XB_EXIT], 0u, RLX_AGENT); } }
    }
#endif
}

extern "C" void kernel_launch(void* const* d_in, const int* in_sizes, int n_in, void* d_out, int out_size, void* d_ws, size_t ws_size, hipStream_t stream) {
    static int grid = 0;
    if (grid == 0) {
        if (n_in != 14 || in_sizes[0] != T * DM || out_size != T * DM || ws_size < WS_END) { fprintf(stderr, "kernel_launch: unexpected shapes (n_in %d, in0 %d, out %d, ws %zu); nothing launched\n", n_in, n_in > 0 ? in_sizes[0] : -1, out_size, ws_size); grid = -1; return; }
        int dev = 0, cus = 0;
        if (hipGetDevice(&dev) != hipSuccess || hipDeviceGetAttribute(&cus, hipDeviceAttributeMultiprocessorCount, dev) != hipSuccess) { grid = -1; return; }
        if (hipFuncSetAttribute((const void*)mega_fwd, hipFuncAttributeMaxDynamicSharedMemorySize, LDS_BYTES) != hipSuccess) { fprintf(stderr, "kernel_launch: hipFuncSetAttribute failed\n"); grid = -1; return; }
        (void)hipGetLastError();
        grid = cus;
        if (grid != 256) fprintf(stderr, "kernel_launch: %d CUs; this kernel is laid out for 256\n", grid);
    }
    if (grid < 0) return;
#if !ONE_LAUNCH
    (void)hipMemsetAsync((char*)d_ws + WS_CTL, 0, CTL_ZERO_BYTES, stream);
#endif
    Args a{};
    for (int i = 0; i < 14; ++i) a.in[i] = (const float*)d_in[i];
    a.out = (float*)d_out; a.ws = (unsigned char*)d_ws;
    int li = 0;
    auto mega = [&](int lo, int hi) { a.ph_lo = lo; a.ph_hi = hi; a.li = li++; hipLaunchKernelGGL(mega_fwd, dim3(grid), dim3(NWAVES * 64), LDS_BYTES, stream, a); };
#if ONE_LAUNCH
    mega(0, NPHASE);
#else
    for (int k = 0; k < NPHASE; ++k) mega(k, k + 1);
#endif
}
```

```cpp
#include <hip/hip_runtime.h>
#include <cstdio>
#include <cstdint>
#include <cmath>
#include <type_traits>

#ifndef ONE_LAUNCH
#define ONE_LAUNCH 1
#endif
#ifndef ROUTER_MFMA
#define ROUTER_MFMA 1
#endif
#ifndef SKIPMASK
#define SKIPMASK 0
#endif
#define SK(b) (!((SKIPMASK) & (b)))
#ifndef DUPMASK
#define DUPMASK 0
#endif
#define NREP(b) (((DUPMASK) & (b)) ? 2 : 1)

#define GAS __attribute__((address_space(1)))
#define LAS __attribute__((address_space(3)))
#define CAS __attribute__((address_space(4)))
typedef unsigned short bf16;
typedef unsigned v4u __attribute__((ext_vector_type(4)));
typedef unsigned v2u __attribute__((ext_vector_type(2)));
typedef float f32x4 __attribute__((ext_vector_type(4)));
typedef float f32x16 __attribute__((ext_vector_type(16)));
typedef short bf16x8 __attribute__((ext_vector_type(8)));
typedef short s16x4 __attribute__((ext_vector_type(4)));

constexpr int NB = 8, SEQ = 2048, DM = 1024, NLAYER = 2, MEMT = 256, INW = 2560;
constexpr int T = NB * SEQ;
constexpr int C_XC = 0, C_BG = 384, C_CG = 768, C_Q = 1152, C_K = 1536, C_V = 1920, C_QM = 2304;
constexpr int NDH = 6, NMH = 4, CONVC = 384;
constexpr int NE = 16, FF = 2048, CAP = 256, ER = NB * CAP;
constexpr float RMS_EPS = 1e-6f;
constexpr float LOG2E = 1.4426950408889634f;

constexpr size_t MiB = 1u << 20;
constexpr size_t WS_CTL = 0, CTL_ZERO_BYTES = 1 * MiB;
constexpr size_t WS_WIN = 2 * MiB;
constexpr size_t WS_WKV = 12 * MiB;
constexpr size_t WS_WOUT = 14 * MiB;
constexpr size_t WS_WGU = 18 * MiB;
constexpr size_t WS_WDN = 274 * MiB;
constexpr size_t WS_XB = 402 * MiB;
constexpr size_t WS_H = 434 * MiB;
constexpr size_t WS_OP = 514 * MiB;
constexpr size_t WS_LSE = 550 * MiB;
constexpr size_t WS_MIX = 552 * MiB;
constexpr size_t WS_MEMN = 584 * MiB;
constexpr size_t WS_KVM = 588 * MiB;
constexpr size_t WS_AFFT = 592 * MiB;
constexpr size_t WS_INV = 593 * MiB;
constexpr size_t WS_GROW = 594 * MiB;
constexpr size_t WS_IDX = 595 * MiB;
constexpr size_t WS_XG = 596 * MiB;
constexpr size_t WS_HID = 660 * MiB;
constexpr size_t WS_X1B = 788 * MiB;
constexpr size_t WS_RS0 = 820 * MiB;
constexpr size_t WS_SS1 = 821 * MiB;
constexpr size_t WS_RS1 = 823 * MiB;
constexpr size_t WS_RSLOT = 824 * MiB;
constexpr size_t WS_X1F8 = 825 * MiB;
constexpr size_t WS_END = 841 * MiB;

constexpr int CW_BAR = 4096;
#define XCD_BAR_WORDS 3456
constexpr int MAX_LAUNCH = 24;
static_assert((CW_BAR + MAX_LAUNCH * XCD_BAR_WORDS) * 4 <= (int)CTL_ZERO_BYTES, "ctl");

constexpr int RING_BYTES = 131072, LDSCTL_OFF = 155648  , MISC_OFF = LDSCTL_OFF + 320, LDSX_OFF = LDSCTL_OFF + 4096  , LDS_BYTES = 163840  ;
constexpr int NWAVES = 8;

#define RLX_AGENT __ATOMIC_RELAXED, __HIP_MEMORY_SCOPE_AGENT
#define LDS_WAIT() asm volatile("s_waitcnt lgkmcnt(0)" ::: "memory")
__device__ __forceinline__ unsigned f2bf(float f) { unsigned u = __builtin_bit_cast(unsigned, f); return (u + 0x7fffu + ((u >> 16) & 1u)) >> 16; }
__device__ __forceinline__ unsigned pk2(float lo, float hi) { return f2bf(lo) | (f2bf(hi) << 16); }
__device__ __forceinline__ unsigned cvtpk_s(float lo, float hi) { typedef float f2 __attribute__((ext_vector_type(2))); typedef __bf16 b2 __attribute__((ext_vector_type(2))); f2 v = {lo, hi}; b2 b = __builtin_convertvector(v, b2); return __builtin_bit_cast(unsigned, b); }
__device__ __forceinline__ float bflo(unsigned w) { return __builtin_bit_cast(float, w << 16); }
__device__ __forceinline__ float bfhi(unsigned w) { return __builtin_bit_cast(float, w & 0xffff0000u); }
__device__ __forceinline__ float bf2f(bf16 v) { return __builtin_bit_cast(float, (unsigned)v << 16); }
__device__ __forceinline__ float wave_sum(float v) {
#pragma unroll
    for (int o = 1; o < 64; o <<= 1) v += __shfl_xor(v, o);
    return v;
}

namespace pg8 {
#define PG8_LAS __attribute__((address_space(3)))
typedef unsigned short bf16_t;
typedef short bf16x8 __attribute__((ext_vector_type(8)));
typedef float f32x4 __attribute__((ext_vector_type(4)));
typedef unsigned u32x4 __attribute__((ext_vector_type(4)));
typedef unsigned u32x2 __attribute__((ext_vector_type(2)));
constexpr int BM = 256, BK = 64, HALF = 128, HTB = HALF * BK * 2  , STAGE_BYTES = 8 * HTB, NXCD = 8, WGM = 8;

__host__ __device__ __forceinline__ int lds_byte(int r, int c) { const int st = (r >> 4) * 2 + (c >> 5), rr = r & 15, cc = c & 31, ob = rr * 64 + cc * 2; return st * 1024 + (ob ^ (((ob >> 9) & 1) << 5)); }
__host__ __device__ __forceinline__ void stage_rc(int b, int& R, int& C) { const int st = b / 1024, sb = b % 1024, swz = sb ^ (((sb >> 9) & 1) << 5); R = (st >> 1) * 16 + swz / 64; C = (st & 1) * 32 + (swz % 64) / 2; }
__host__ __device__ __forceinline__ int perm32(int rho) { const int n = rho >> 4, i = rho & 15; return 8 * (i >> 2) + 4 * n + (i & 3); }

typedef int i32x4 __attribute__((ext_vector_type(4)));
typedef int i32x8 __attribute__((ext_vector_type(8)));
__device__ __forceinline__ i32x8 cat8(bf16x8 a, bf16x8 b) { const i32x4 x = __builtin_bit_cast(i32x4, a), y = __builtin_bit_cast(i32x4, b); return __builtin_shufflevector(x, y, 0, 1, 2, 3, 4, 5, 6, 7); }
__device__ __forceinline__ unsigned pk4_e4m3(float a, float b, float c, float d) {
    a = __builtin_amdgcn_fmed3f(a, -448.f, 448.f); b = __builtin_amdgcn_fmed3f(b, -448.f, 448.f); c = __builtin_amdgcn_fmed3f(c, -448.f, 448.f); d = __builtin_amdgcn_fmed3f(d, -448.f, 448.f);
    int w = __builtin_amdgcn_cvt_pk_fp8_f32(a, b, 0, false); w = __builtin_amdgcn_cvt_pk_fp8_f32(c, d, w, true); return (unsigned)w; }
__device__ __forceinline__ void mfma8(f32x4& acc, i32x8 a, i32x8 b) { asm volatile("v_mfma_f32_16x16x128_f8f6f4 %0, %1, %2, %0" : "+v"(acc) : "v"(a), "v"(b)); }
struct Unit { int pm, pn; };
struct Gemm { const bf16_t* A; const bf16_t* Bt; int M, N, K; int gm; size_t gstride; const int* aidx; };

struct StaticOrder {
    int nM, nN, nwg, G, c;
    __host__ __device__ void init(int M, int N, int G_, int c_) { nM = M / BM; nN = N / BM; nwg = nM * nN; G = G_; c = c_; }
    __host__ __device__ bool next(int i, Unit& u) const {
        const long L = (long)i * G + c; if (L >= nwg) return false;
        int wgid = (int)L; { const int q = nwg / NXCD, r = nwg % NXCD, xcd = wgid % NXCD, off = wgid / NXCD; wgid = (xcd < r ? xcd * (q + 1) : r * (q + 1) + (xcd - r) * q) + off; }
        const int nig = WGM * nN, gid = wgid / nig, fm = gid * WGM, gsz = (nM - fm) < WGM ? (nM - fm) : WGM;
        u.pm = fm + ((wgid % nig) % gsz); u.pn = (wgid % nig) / gsz; return true;
    }
    __device__ __forceinline__ void a_ready(const Unit&) const {}
    __device__ __forceinline__ void done(const Unit&) const {}
};

struct ExpertOrder {
    int pm, pn0;
    __device__ __forceinline__ void init(int vcu) { pm = (vcu >> 4) * 8 + (vcu & 7); pn0 = ((vcu >> 3) & 1) * 8; }
    __device__ __forceinline__ bool next(int i, Unit& u) const { if (i >= 8) return false; u.pm = pm; u.pn = pn0 + i; return true; }
    __device__ __forceinline__ void a_ready(const Unit&) const {}
    __device__ __forceinline__ void done(const Unit&) const {}
};

__device__ __forceinline__ unsigned cvt_pk_bf16(float lo, float hi) { unsigned r; asm volatile("v_cvt_pk_bf16_f32 %0, %1, %2" : "=v"(r) : "v"(lo), "v"(hi)); return r; }

struct EpiBf16 {
    static constexpr bool PERM = true, AFTER_DRAIN = false;
    bf16_t* O; int ldc; const float* rscale;
    __device__ __forceinline__ void operator()(const f32x4 (&acc)[2][2][4][2], const Unit& u, int wr, int wc, int fr, int fq) const {
        int row0 = u.pm * BM + wr * 64 + fr; asm volatile("" : "+v"(row0));
        const int col0 = u.pn * BM + wc * 32 + 8 * fq;
#pragma unroll
        for (int ai = 0; ai < 2; ++ai)
#pragma unroll
            for (int m = 0; m < 4; ++m) { const int row = row0 + ai * HALF + m * 16; bf16_t* rowp = O + (size_t)row * ldc + col0;
                const float sc = rscale ? rscale[row] : 1.f;
#pragma unroll
                for (int bj = 0; bj < 2; ++bj) { const f32x4 v0 = acc[ai][bj][m][0] * sc, v1 = acc[ai][bj][m][1] * sc;
                    u32x4 w; w.x = cvt_pk_bf16(v0[0], v0[1]); w.y = cvt_pk_bf16(v0[2], v0[3]); w.z = cvt_pk_bf16(v1[0], v1[1]); w.w = cvt_pk_bf16(v1[2], v1[3]);
                    *(u32x4*)(rowp + bj * HALF) = w; } }
    }
};
struct EpiF8 {
    static constexpr bool PERM = true, AFTER_DRAIN = false;
    unsigned char* O; int ldc; const float* rscale;
    __device__ __forceinline__ void operator()(const f32x4 (&acc)[2][2][4][2], const Unit& u, int wr, int wc, int fr, int fq) const {
        int row0 = u.pm * BM + wr * 64 + fr; asm volatile("" : "+v"(row0));
        const int col0 = u.pn * BM + wc * 32 + 8 * fq;
#pragma unroll
        for (int ai = 0; ai < 2; ++ai)
#pragma unroll
            for (int m = 0; m < 4; ++m) { const int row = row0 + ai * HALF + m * 16; unsigned char* rowp = O + (size_t)row * ldc + col0;
                const float sc = rscale[row];
#pragma unroll
                for (int bj = 0; bj < 2; ++bj) { const f32x4 v0 = acc[ai][bj][m][0] * sc, v1 = acc[ai][bj][m][1] * sc;
                    u32x2 w; w.x = pk4_e4m3(v0[0], v0[1], v0[2], v0[3]); w.y = pk4_e4m3(v1[0], v1[1], v1[2], v1[3]);
                    *(u32x2*)(rowp + bj * HALF) = w; } }
    }
};
struct EpiResBf16 {
    static constexpr bool PERM = true, AFTER_DRAIN = false;
    const bf16_t* base; bf16_t* out; int ldc; float* ss; unsigned char* o8; float s8;
    __device__ __forceinline__ void operator()(const f32x4 (&acc)[2][2][4][2], const Unit& u, int wr, int wc, int fr, int fq) const {
        int row0 = u.pm * BM + wr * 64 + fr; asm volatile("" : "+v"(row0));
        const int col0 = u.pn * BM + wc * 32 + 8 * fq;
#pragma unroll
        for (int ai = 0; ai < 2; ++ai) {
            u32x4 b[4][2];
#pragma unroll
            for (int m = 0; m < 4; ++m)
#pragma unroll
                for (int bj = 0; bj < 2; ++bj) b[m][bj] = *(const u32x4*)(base + (size_t)(row0 + ai * HALF + m * 16) * ldc + col0 + bj * HALF);
#pragma unroll
            for (int m = 0; m < 4; ++m) { const int row = row0 + ai * HALF + m * 16; float q = 0.f;
#pragma unroll
                for (int bj = 0; bj < 2; ++bj) { const u32x4 bb = b[m][bj]; f32x4 v0 = acc[ai][bj][m][0], v1 = acc[ai][bj][m][1];
                    v0[0] += __builtin_bit_cast(float, bb.x << 16); v0[1] += __builtin_bit_cast(float, bb.x & 0xffff0000u); v0[2] += __builtin_bit_cast(float, bb.y << 16); v0[3] += __builtin_bit_cast(float, bb.y & 0xffff0000u);
                    v1[0] += __builtin_bit_cast(float, bb.z << 16); v1[1] += __builtin_bit_cast(float, bb.z & 0xffff0000u); v1[2] += __builtin_bit_cast(float, bb.w << 16); v1[3] += __builtin_bit_cast(float, bb.w & 0xffff0000u);
                    q += (v0[0] * v0[0] + v0[1] * v0[1]) + (v0[2] * v0[2] + v0[3] * v0[3]) + (v1[0] * v1[0] + v1[1] * v1[1]) + (v1[2] * v1[2] + v1[3] * v1[3]);
                    u32x4 w; w.x = cvt_pk_bf16(v0[0], v0[1]); w.y = cvt_pk_bf16(v0[2], v0[3]); w.z = cvt_pk_bf16(v1[0], v1[1]); w.w = cvt_pk_bf16(v1[2], v1[3]);
                    *(u32x4*)(out + (size_t)row * ldc + col0 + bj * HALF) = w;
                    if (o8) { u32x2 w8; w8.x = pk4_e4m3(v0[0] * s8, v0[1] * s8, v0[2] * s8, v0[3] * s8); w8.y = pk4_e4m3(v1[0] * s8, v1[1] * s8, v1[2] * s8, v1[3] * s8);
                        *(u32x2*)(o8 + (size_t)row * ldc + col0 + bj * HALF) = w8; } }
                q += __shfl_xor(q, 16); q += __shfl_xor(q, 32);
                if (fq == 0) ss[(size_t)row * 16 + 4 * u.pn + wc] = q; }
        }
    }
};
__device__ __forceinline__ float silu_mul(float g, float u) { return g * __builtin_amdgcn_rcpf(1.0f + __builtin_amdgcn_exp2f(-1.4426950408889634f * g)) * u; }
struct EpiSwiGLU {
    static constexpr bool PERM = true, AFTER_DRAIN = false;
    bf16_t* O; int ldc; const float* rscale;
    __device__ __forceinline__ void operator()(const f32x4 (&acc)[2][2][4][2], const Unit& u, int wr, int wc, int fr, int fq) const {
        int row0 = u.pm * BM + wr * 64 + fr; asm volatile("" : "+v"(row0));
        const int col0 = u.pn * HALF + wc * 32 + 8 * fq;
#pragma unroll
        for (int ai = 0; ai < 2; ++ai)
#pragma unroll
            for (int m = 0; m < 4; ++m) { const int row = row0 + ai * HALF + m * 16; bf16_t* rowp = O + (size_t)row * ldc + col0; const float sc = rscale[row];
                const f32x4 g0 = acc[ai][0][m][0] * sc, g1 = acc[ai][0][m][1] * sc, u0 = acc[ai][1][m][0] * sc, u1 = acc[ai][1][m][1] * sc;
                u32x4 w; w.x = cvt_pk_bf16(silu_mul(g0[0], u0[0]), silu_mul(g0[1], u0[1])); w.y = cvt_pk_bf16(silu_mul(g0[2], u0[2]), silu_mul(g0[3], u0[3]));
                w.z = cvt_pk_bf16(silu_mul(g1[0], u1[0]), silu_mul(g1[1], u1[1])); w.w = cvt_pk_bf16(silu_mul(g1[2], u1[2]), silu_mul(g1[3], u1[3]));
                *(u32x4*)rowp = w; }
    }
};

struct EpiSwiGLU8 {
    static constexpr bool PERM = true, AFTER_DRAIN = false;
    unsigned char* O; int ldc; const float* rscale; float oscale;
    __device__ __forceinline__ void operator()(const f32x4 (&acc)[2][2][4][2], const Unit& u, int wr, int wc, int fr, int fq) const {
        int row0 = u.pm * BM + wr * 64 + fr; asm volatile("" : "+v"(row0));
        const int col0 = u.pn * HALF + wc * 32 + 8 * fq;
#pragma unroll
        for (int ai = 0; ai < 2; ++ai)
#pragma unroll
            for (int m = 0; m < 4; ++m) { const int row = row0 + ai * HALF + m * 16; unsigned char* rowp = O + (size_t)row * ldc + col0; const float sc = rscale[row], su = sc * oscale;
                const f32x4 g0 = acc[ai][0][m][0] * sc, g1 = acc[ai][0][m][1] * sc, u0 = acc[ai][1][m][0] * su, u1 = acc[ai][1][m][1] * su;
                u32x2 w; w.x = pk4_e4m3(silu_mul(g0[0], u0[0]), silu_mul(g0[1], u0[1]), silu_mul(g0[2], u0[2]), silu_mul(g0[3], u0[3]));
                w.y = pk4_e4m3(silu_mul(g1[0], u1[0]), silu_mul(g1[1], u1[1]), silu_mul(g1[2], u1[2]), silu_mul(g1[3], u1[3]));
                *(u32x2*)rowp = w; }
    }
};

template <class Epi, class Sched, bool ALIGN_EPI = false, bool SP2 = false, bool GATHER = false, bool FP8 = false>
__device__ __forceinline__ void gemm_phase(PG8_LAS unsigned char* lds, const Gemm g, const Sched& S, const Epi& E) {
    int tid_ = threadIdx.x; asm volatile("" : "+v"(tid_));
    const int tid = tid_, wid = __builtin_amdgcn_readfirstlane(tid >> 6), lane = tid & 63, wr = wid >> 2, wc = wid & 3, fr = lane & 15, fq = lane >> 4;
    const int K = g.K, nt = K / BK;
    unsigned voffA[2], voffA1[2], voffB[2];
    const size_t hstep = (size_t)HALF * K * 2;
    Unit cur, nxt; int ui = 0;
    if (!S.next(0, cur)) return;
#pragma unroll
    for (int i = 0; i < 2; ++i) { int R, C; stage_rc(tid * 16 + i * 8192, R, C); const int Rb = Epi::PERM ? ((R & ~31) + perm32(R & 31)) : R;
        if constexpr (GATHER) { const int r0 = g.aidx[cur.pm * BM + R], r1 = g.aidx[cur.pm * BM + HALF + R]; voffA[i] = (unsigned)(r0 * K + C) * 2u; voffA1[i] = (unsigned)(r1 * K + C) * 2u; }
        else { voffA[i] = (unsigned)(R * K + C) * 2u; voffA1[i] = voffA[i] + (unsigned)hstep; }
        voffB[i] = (unsigned)(Rb * K + C) * 2u; }
    const size_t kstep = (size_t)(BK * 2);
    const size_t tstep = 2 * hstep;
    const size_t gbytes = g.gstride * 2;
    const unsigned ldsw = (unsigned)wid * 1024u;
    const int aoff = lds_byte(wr * 64 + fr, fq * 8), boff = lds_byte(wc * 32 + fr, fq * 8);
#define PG8_SA(b, h) (((b) * 2 + (h)) * HTB)
#define PG8_SB(b, h) ((4 + (b) * 2 + (h)) * HTB)
#define PG8_STAGE(bufoff, gbase, voff) do { _Pragma("unroll") for (int _i = 0; _i < 2; ++_i) \
        __builtin_amdgcn_global_load_lds((const unsigned*)((const char*)(gbase) + (voff)[_i]), (PG8_LAS unsigned*)(lds + (bufoff) + ldsw + _i * 8192), 16, 0, 0); } while (0)
#define PG8_LDA(dst, b, h) do { _Pragma("unroll") for (int m = 0; m < 4; ++m) _Pragma("unroll") for (int k = 0; k < 2; ++k) dst[m][k] = *(const PG8_LAS bf16x8*)(lds + PG8_SA(b, h) + aoff + m * 2048 + k * 1024); } while (0)
#define PG8_LDB(dst, b, h) do { _Pragma("unroll") for (int n = 0; n < 2; ++n) _Pragma("unroll") for (int k = 0; k < 2; ++k) dst[n][k] = *(const PG8_LAS bf16x8*)(lds + PG8_SB(b, h) + boff + n * 2048 + k * 1024); } while (0)
#define PG8_MMA(ai, bj, At, Bt) do { __builtin_amdgcn_s_setprio(1); \
        if constexpr (FP8) { _Pragma("unroll") for (int m = 0; m < 4; ++m) _Pragma("unroll") for (int n = 0; n < 2; ++n) \
            mfma8(acc[ai][bj][m][n], cat8(Bt[n][0], Bt[n][1]), cat8(At[m][0], At[m][1])); } \
        else { _Pragma("unroll") for (int m = 0; m < 4; ++m) _Pragma("unroll") for (int n = 0; n < 2; ++n) _Pragma("unroll") for (int k = 0; k < 2; ++k) \
            acc[ai][bj][m][n] = __builtin_amdgcn_mfma_f32_16x16x32_bf16(Bt[n][k], At[m][k], acc[ai][bj][m][n], 0, 0, 0); } \
        __builtin_amdgcn_s_setprio(0); } while (0)
#define PG8_WAIT_V(n) asm volatile("s_waitcnt vmcnt(" #n ")" ::: "memory")
#define PG8_WAIT_L(n) asm volatile("s_waitcnt lgkmcnt(" #n ")" ::: "memory")
#define PG8_BAR __builtin_amdgcn_s_barrier()
#define PG8_SCHED __builtin_amdgcn_sched_barrier(0)
    f32x4 acc[2][2][4][2];
#pragma unroll
    for (int a = 0; a < 2; ++a)
#pragma unroll
        for (int b = 0; b < 2; ++b)
#pragma unroll
            for (int m = 0; m < 4; ++m)
#pragma unroll
                for (int n = 0; n < 2; ++n) acc[a][b][m][n] = (f32x4){0.f, 0.f, 0.f, 0.f};
    bf16x8 At[4][2], B0[2][2], B1[2][2];
    const char* cA = (const char*)g.A + (GATHER ? (size_t)0 : (size_t)cur.pm * tstep); const char* cB = (const char*)g.Bt + (size_t)(cur.pm / g.gm) * gbytes + (size_t)cur.pn * tstep;
    S.a_ready(cur);
    if constexpr (SP2) {
        PG8_STAGE(PG8_SB(0, 0), cB, voffB); PG8_STAGE(PG8_SB(0, 1), cB + hstep, voffB); PG8_STAGE(PG8_SA(0, 0), cA, voffA); PG8_STAGE(PG8_SA(0, 1), cA, voffA1);
        if (wr == 1) PG8_BAR;
        PG8_WAIT_V(2); PG8_BAR;
        PG8_STAGE(PG8_SB(1, 0), cB + kstep, voffB); PG8_STAGE(PG8_SA(1, 0), cA + kstep, voffA); PG8_STAGE(PG8_SB(1, 1), cB + hstep + kstep, voffB);
        PG8_WAIT_V(6); PG8_BAR;
    } else {
        PG8_STAGE(PG8_SB(0, 0), cB, voffB); PG8_STAGE(PG8_SA(0, 0), cA, voffA); PG8_STAGE(PG8_SB(0, 1), cB + hstep, voffB); PG8_STAGE(PG8_SA(0, 1), cA, voffA1);
        if (wr == 1) PG8_BAR;
        PG8_WAIT_V(4); PG8_BAR;
        PG8_STAGE(PG8_SB(1, 0), cB + kstep, voffB); PG8_STAGE(PG8_SA(1, 0), cA + kstep, voffA); PG8_STAGE(PG8_SB(1, 1), cB + hstep + kstep, voffB);
        PG8_WAIT_V(6); PG8_BAR;
    }
    for (;;) {
        const bool has_next = S.next(ui + 1, nxt);
        const char* nA = (has_next && !GATHER) ? (const char*)g.A + (size_t)nxt.pm * tstep : cA; const char* nB = has_next ? (const char*)g.Bt + (size_t)(nxt.pm / g.gm) * gbytes + (size_t)nxt.pn * tstep : cB;
        for (int t = 0; t < nt; t += 2) {
            const bool last = (t == nt - 2);
            const char* a1 = cA + (size_t)(t + 1) * kstep;
            const char* a2 = last ? nA : cA + (size_t)(t + 2) * kstep; const char* b2 = last ? nB : cB + (size_t)(t + 2) * kstep;
            const char* a3 = a2 + kstep; const char* b3 = b2 + kstep;
            if (last && has_next) S.a_ready(nxt);
            if constexpr (SP2) {
            PG8_LDB(B0, 0, 0); PG8_LDB(B1, 0, 1); PG8_SCHED; PG8_LDA(At, 0, 0); PG8_STAGE(PG8_SA(1, 1), a1, voffA1);
            PG8_WAIT_V(8); PG8_WAIT_L(0); PG8_BAR; PG8_MMA(0, 0, At, B0); PG8_MMA(0, 1, At, B1); PG8_BAR; PG8_SCHED;
            PG8_LDA(At, 0, 1); PG8_STAGE(PG8_SB(0, 0), b2, voffB); PG8_STAGE(PG8_SB(0, 1), b2 + hstep, voffB); PG8_STAGE(PG8_SA(0, 0), a2, voffA);
            PG8_WAIT_V(8); PG8_WAIT_L(0); PG8_BAR; PG8_MMA(1, 0, At, B0); PG8_MMA(1, 1, At, B1); PG8_BAR; PG8_SCHED;
            PG8_LDB(B0, 1, 0); PG8_LDB(B1, 1, 1); PG8_SCHED; PG8_LDA(At, 1, 0); PG8_STAGE(PG8_SA(0, 1), a2, voffA1);
            PG8_WAIT_V(8); PG8_WAIT_L(0); PG8_BAR; PG8_MMA(0, 0, At, B0); PG8_MMA(0, 1, At, B1); PG8_BAR; PG8_SCHED;
            PG8_LDA(At, 1, 1); PG8_STAGE(PG8_SB(1, 0), b3, voffB); PG8_STAGE(PG8_SB(1, 1), b3 + hstep, voffB); PG8_STAGE(PG8_SA(1, 0), a3, voffA);
            PG8_WAIT_V(8); PG8_WAIT_L(0); PG8_BAR; PG8_MMA(1, 0, At, B0); PG8_MMA(1, 1, At, B1); PG8_BAR; PG8_SCHED;
            } else {
            PG8_LDB(B0, 0, 0); PG8_SCHED; PG8_LDA(At, 0, 0); PG8_STAGE(PG8_SA(1, 1), a1, voffA1);
            PG8_WAIT_L(8); PG8_BAR; PG8_WAIT_L(0); PG8_MMA(0, 0, At, B0); PG8_BAR; PG8_SCHED;
            PG8_LDB(B1, 0, 1); PG8_STAGE(PG8_SB(0, 0), b2, voffB);
            PG8_BAR; PG8_WAIT_L(0); PG8_MMA(0, 1, At, B1); PG8_BAR;
            PG8_LDA(At, 0, 1); PG8_STAGE(PG8_SA(0, 0), a2, voffA);
            PG8_BAR; PG8_WAIT_L(0); PG8_MMA(1, 0, At, B0); PG8_BAR; PG8_SCHED;
            PG8_STAGE(PG8_SB(0, 1), b2 + hstep, voffB);
            PG8_WAIT_V(6); PG8_BAR; PG8_MMA(1, 1, At, B1); PG8_BAR;
            PG8_LDB(B0, 1, 0); PG8_SCHED; PG8_LDA(At, 1, 0); PG8_STAGE(PG8_SA(0, 1), a2, voffA1);
            PG8_WAIT_L(8); PG8_BAR; PG8_WAIT_L(0); PG8_MMA(0, 0, At, B0); PG8_BAR; PG8_SCHED;
            PG8_LDB(B1, 1, 1); PG8_STAGE(PG8_SB(1, 0), b3, voffB);
            PG8_BAR; PG8_WAIT_L(0); PG8_MMA(0, 1, At, B1); PG8_BAR;
            PG8_LDA(At, 1, 1); PG8_STAGE(PG8_SA(1, 0), a3, voffA);
            PG8_BAR; PG8_WAIT_L(0); PG8_MMA(1, 0, At, B0); PG8_BAR; PG8_SCHED;
            PG8_STAGE(PG8_SB(1, 1), b3 + hstep, voffB);
            PG8_WAIT_V(6); PG8_BAR; PG8_MMA(1, 1, At, B1); PG8_BAR;
            }
        }
        if constexpr (FP8) asm volatile("s_nop 15\n\ts_nop 15" ::: "memory");
        if constexpr (ALIGN_EPI) { if (wr == 0) PG8_BAR; }
        if constexpr (!Epi::AFTER_DRAIN) { E(acc, cur, wr, wc, fr, fq); S.done(cur); }
        if (!has_next) break;
#pragma unroll
        for (int a = 0; a < 2; ++a)
#pragma unroll
            for (int b = 0; b < 2; ++b)
#pragma unroll
                for (int m = 0; m < 4; ++m)
#pragma unroll
                    for (int n = 0; n < 2; ++n) acc[a][b][m][n] = (f32x4){0.f, 0.f, 0.f, 0.f};
        cur = nxt; cA = nA; cB = nB; ++ui;
        if constexpr (ALIGN_EPI) { if (wr == 1) PG8_BAR; }
    }
    PG8_WAIT_V(0);
    if constexpr (!ALIGN_EPI) { if (wr == 0) PG8_BAR; }
    PG8_BAR;
#undef PG8_SA
#undef PG8_SB
#undef PG8_STAGE
#undef PG8_LDA
#undef PG8_LDB
#undef PG8_MMA
#undef PG8_WAIT_V
#undef PG8_WAIT_L
#undef PG8_BAR
#undef PG8_SCHED
}
}

typedef GAS unsigned gu32;
#define XB_TMO      128
#define XB_XCNT(j)  (256  + 64 * (j))
#define XB_XSUB(j)  (1280 + 64 * (j))
#define XB_XGEN(j)  (2304 + 64 * (j))
#define XB_TOP      3328
#define XB_TOPGEN   3392
#define XB_SPIN_CAP (1u << 20)

__device__ __forceinline__ unsigned xb_ld(unsigned* p)              { return __hip_atomic_load(p, __ATOMIC_RELAXED, __HIP_MEMORY_SCOPE_AGENT); }
__device__ __forceinline__ unsigned xb_add(unsigned* p, unsigned v) { return __hip_atomic_fetch_add(p, v, __ATOMIC_RELAXED, __HIP_MEMORY_SCOPE_AGENT); }
__device__ __forceinline__ unsigned xb_xcc_id() { return (unsigned)__builtin_amdgcn_s_getreg((3 << 11) | 20) & 0xFu; }
#define XB_SPIN(cond, bar) do { unsigned _sp = 0; while (cond) { __builtin_amdgcn_s_sleep(1); \
    if ((++_sp & 255u) == 0u) { if (xb_ld(&(bar)[XB_TMO])) break; if (_sp > XB_SPIN_CAP) { atomicAdd(&(bar)[XB_TMO], 1u); break; } } } } while (0)

#define XB_EXIT     3456
#if ONE_LAUNCH
__device__ unsigned g_barrier_words[XB_EXIT + 64];
#endif
struct XcdBarrier { unsigned* bar; unsigned x; volatile LAS unsigned* st; };
__device__ __forceinline__ XcdBarrier xcd_barrier_post(unsigned* bar, volatile LAS unsigned* st) {
    XcdBarrier b; b.bar = bar; b.x = xb_xcc_id(); b.st = st;
    if (threadIdx.x == 0) (void)xb_add(&bar[XB_XCNT(b.x)], 1u);
    return b;
}
__device__ __forceinline__ void xcd_barrier_complete(unsigned* bar, unsigned x, unsigned& nloc, unsigned& nx) {
    const unsigned G = gridDim.x * gridDim.y * gridDim.z;
    unsigned sum, cnt, mine, sp = 0u;
    for (;;) {
        sum = 0u; cnt = 0u; mine = 0u;
#pragma unroll
        for (unsigned j = 0; j < 16; ++j) { const unsigned c = xb_ld(&bar[XB_XCNT(j)]); sum += c; cnt += (c > 0u) ? 1u : 0u; mine = (j == x) ? c : mine; }
        if (sum == G) break;
        __builtin_amdgcn_s_sleep(1);
        if ((++sp & 255u) == 0u) { if (xb_ld(&bar[XB_TMO])) break; if (sp > XB_SPIN_CAP) { atomicAdd(&bar[XB_TMO], 1u); break; } }
    }
    nloc = mine > 0u ? mine : 1u; nx = cnt > 0u ? cnt : 1u;
}
__device__ __forceinline__ void xcd_barrier(const XcdBarrier& b, bool opp = false) {
    asm volatile("s_waitcnt vmcnt(0)" ::: "memory");
    __syncthreads();
    if (threadIdx.x == 0) {
        unsigned* bar = b.bar;
        __builtin_amdgcn_s_waitcnt(0);
        unsigned nloc = b.st[0], nx = b.st[1];
        if (nloc == 0u) { xcd_barrier_complete(bar, b.x, nloc, nx); b.st[0] = nloc; b.st[1] = nx; }
        const unsigned old = xb_add(&bar[XB_XSUB(b.x)], 1u);
        const unsigned gen = old / nloc;
        b.st[2] = 0u;
        if (opp && (old - gen * nloc) < (nloc >> 1)) { b.st[2] = 1u; b.st[3] = gen; }
        else if (old + 1u == (gen + 1u) * nloc) {
            __builtin_amdgcn_fence(__ATOMIC_RELEASE, "agent");
            asm volatile("s_waitcnt vmcnt(0)" ::: "memory");
            const unsigned og = xb_add(&bar[XB_TOP], 1u);
            const unsigned tg = og / nx;
            if (og + 1u == (tg + 1u) * nx) xb_add(&bar[XB_TOPGEN], 1u);
            else XB_SPIN(xb_ld(&bar[XB_TOPGEN]) == tg, bar);
            __builtin_amdgcn_fence(__ATOMIC_ACQUIRE, "agent");
            xb_add(&bar[XB_XGEN(b.x)], 1u);
            asm volatile("s_waitcnt vmcnt(0)" ::: "memory");
        } else {
            XB_SPIN(xb_ld(&bar[XB_XGEN(b.x)]) == gen, bar);
            __builtin_amdgcn_fence(__ATOMIC_ACQUIRE, "agent");
            asm volatile("s_waitcnt vmcnt(0)" ::: "memory");
        }
    }
    __syncthreads();
}
__device__ __forceinline__ void xcd_barrier_wait(const XcdBarrier& b) {
    __syncthreads();
    if (threadIdx.x == 0) {
        const unsigned gen = b.st[3];
        XB_SPIN(xb_ld(&b.bar[XB_XGEN(b.x)]) == gen, b.bar);
        __builtin_amdgcn_fence(__ATOMIC_ACQUIRE, "agent");
        asm volatile("s_waitcnt vmcnt(0)" ::: "memory");
    }
    __syncthreads();
}

struct Frame {
    LAS unsigned char* lds;
    int tid, lane, wave, vcu, G;
    const float *x, *mem, *mem_norm, *norm_mix, *w_in, *conv_w, *w_mem_kv, *w_out, *norm_ffn, *w_router, *w_gate, *w_up, *w_down, *norm_final;
    float* out;
    bf16 *WIN, *WKV, *WOUT, *WGU, *WDN, *XB, *X1B, *H, *OP, *MIX, *MEMN, *KVM, *XG, *HID;
    float *LSE, *AFFT, *GROW, *RS0, *SS1, *RS1, *RSLOT; short* INV; int* IDX; unsigned char* X1F8;
};

__device__ __forceinline__ void tr_item(const float* W, int K, int N, bf16* WT, int mode, const float* gk, LAS float* scr, int item, int lane) {
    const int nblk = N / 32, kb = item / nblk, nb = item % nblk, k0 = 64 * kb, n0 = 32 * nb;
    const int drow0 = (mode == 0) ? n0 : ((n0 >> 7) * 256 + (n0 & 127) + (mode == 2 ? 128 : 0));
    { f32x4 w[8];
#pragma unroll
      for (int i = 0; i < 8; ++i) w[i] = __builtin_nontemporal_load((const GAS f32x4*)(W + (size_t)(k0 + 8 * i + (lane >> 3)) * N + n0 + 4 * (lane & 7)));
#pragma unroll
      for (int i = 0; i < 8; ++i) { const float gg = gk ? gk[k0 + 8 * i + (lane >> 3)] : 1.f; LAS float* d = scr + (8 * i + (lane >> 3)) * 33 + 4 * (lane & 7); d[0] = w[i].x * gg; d[1] = w[i].y * gg; d[2] = w[i].z * gg; d[3] = w[i].w * gg; } }
    LDS_WAIT(); asm volatile("" ::: "memory");
    const int c = lane & 7;
#pragma unroll
    for (int j = 0; j < 4; ++j) { const int n = (lane >> 3) + 8 * j; const LAS float* s = scr + (8 * c) * 33 + n;
        v4u o; o.x = cvtpk_s(s[0 * 33], s[1 * 33]); o.y = cvtpk_s(s[2 * 33], s[3 * 33]); o.z = cvtpk_s(s[4 * 33], s[5 * 33]); o.w = cvtpk_s(s[6 * 33], s[7 * 33]);
        __builtin_nontemporal_store(o, (GAS v4u*)(WT + (size_t)(drow0 + n) * K + k0 + 8 * c)); }
    LDS_WAIT(); asm volatile("" ::: "memory");
}
__device__ __forceinline__ void tr_item8(const float* W, int K, int N, unsigned char* WT, int mode, const float* gk, float sc, LAS float* scr, int item, int lane) {
    const int nblk = N / 32, kb = item / nblk, nb = item % nblk, k0 = 128 * kb, n0 = 32 * nb;
    const int drow0 = (mode == 0) ? n0 : ((n0 >> 7) * 256 + (n0 & 127) + (mode == 2 ? 128 : 0));
#pragma unroll
    for (int h = 0; h < 2; ++h) { f32x4 w[8];
#pragma unroll
      for (int i = 0; i < 8; ++i) w[i] = __builtin_nontemporal_load((const GAS f32x4*)(W + (size_t)(k0 + 64 * h + 8 * i + (lane >> 3)) * N + n0 + 4 * (lane & 7)));
#pragma unroll
      for (int i = 0; i < 8; ++i) { const int r = 64 * h + 8 * i + (lane >> 3); const float gg = gk ? gk[k0 + r] * sc : sc; LAS float* d = scr + r * 33 + 4 * (4 * h + (i >> 1)) + 4 * (lane & 7);
          d[0] = w[i].x * gg; d[1] = w[i].y * gg; d[2] = w[i].z * gg; d[3] = w[i].w * gg; } }
    LDS_WAIT(); asm volatile("" ::: "memory");
    const int c = lane & 7;
#pragma unroll
    for (int j = 0; j < 4; ++j) { const int n = (lane >> 3) + 8 * j; const LAS float* s = scr + (16 * c) * 33 + 4 * c + n;
        v4u o; o.x = pg8::pk4_e4m3(s[0 * 33], s[1 * 33], s[2 * 33], s[3 * 33]); o.y = pg8::pk4_e4m3(s[4 * 33], s[5 * 33], s[6 * 33], s[7 * 33]);
        o.z = pg8::pk4_e4m3(s[8 * 33], s[9 * 33], s[10 * 33], s[11 * 33]); o.w = pg8::pk4_e4m3(s[12 * 33], s[13 * 33], s[14 * 33], s[15 * 33]);
        __builtin_nontemporal_store(o, (GAS v4u*)(WT + (size_t)(drow0 + n) * K + k0 + 16 * c)); }
    LDS_WAIT(); asm volatile("" ::: "memory");
}
__device__ __forceinline__ void rms_row_to_bf16(const float* xrow, const float* g, bf16* orow, int lane) {
    const GAS f32x4* xr = (const GAS f32x4*)xrow + lane; const GAS f32x4* gr = (const GAS f32x4*)g + lane;
    f32x4 v[4]; float s = 0.f;
#pragma unroll
    for (int j = 0; j < 4; ++j) { v[j] = xr[64 * j]; s += (v[j].x * v[j].x + v[j].y * v[j].y) + (v[j].z * v[j].z + v[j].w * v[j].w); }
    const float r = 1.0f / sqrtf(wave_sum(s) * (1.f / DM) + RMS_EPS);
    GAS unsigned long long* o8 = (GAS unsigned long long*)orow + lane;
#pragma unroll
    for (int j = 0; j < 4; ++j) { const f32x4 gg = gr[64 * j]; const f32x4 o = v[j] * r * gg;
        o8[64 * j] = (unsigned long long)pk2(o.x, o.y) | ((unsigned long long)pk2(o.z, o.w) << 32); }
}
constexpr bool GU8 = true, DN8 = true;
constexpr float SC_X1 = 16.f, SC_WGU = 128.f, SC_HID = 8.f, SC_WDN = 256.f, SC_Y = 64.f;
constexpr bool Y8 = true;
constexpr int CSCR_BYTES = 17408;
constexpr int CV_IN = 16 * 80, CV_KV = 16 * 16, CV_OUT = 16 * 32, CV_SMALL = CV_IN + CV_KV + CV_OUT, CV_GU = GU8 ? 512 : 1024, CV_DN = DN8 ? 512 : 1024, CV_LE = 2 * CV_GU + CV_DN, NITEMS = 2 * CV_SMALL + 2 * NE * CV_LE;
constexpr int DEFER_PER = GU8 ? 4 : 8;
constexpr int DEFER_WG0 = 160, N_DEFER0 = (256 - DEFER_WG0) * NWAVES * DEFER_PER;
constexpr int DEFER_WG1 = 128, N_DEFER1 = (256 - DEFER_WG1) * NWAVES * DEFER_PER;
constexpr int ATT_TAIL = GU8 ? 2 : 3, N_ATTT = 128 * NWAVES * ATT_TAIL;
constexpr int OPP_ROUNDS = 6, N_OPP = OPP_ROUNDS * 256 * NWAVES;
constexpr int OPP_LAST_PHASE = 1 + 9 + 3;
constexpr int N_DEFER = N_DEFER0 + N_DEFER1 + 2 * N_ATTT;
__device__ __forceinline__ void conv_item(Frame& F, int it, LAS float* scr) {
    if (it < 2 * CV_SMALL) {
        const int l = it / CV_SMALL; int r = it % CV_SMALL;
        if (r < CV_IN) { tr_item(F.w_in + (size_t)l * DM * INW, DM, INW, F.WIN + (size_t)l * INW * DM, 0, F.norm_mix + (size_t)l * DM, scr, r, F.lane); return; } r -= CV_IN;
        if (r < CV_KV) { tr_item(F.w_mem_kv + (size_t)l * DM * 512, DM, 512, F.WKV + (size_t)l * 512 * DM, 0, nullptr, scr, r, F.lane); return; } r -= CV_KV;
        tr_item(F.w_out + (size_t)l * DM * DM, DM, DM, F.WOUT + (size_t)l * DM * DM, 0, nullptr, scr, r, F.lane);
    } else {
        const int r = it - 2 * CV_SMALL; const int le = r / CV_LE, q = r % CV_LE;
        if (q < 2 * CV_GU) { const int up = q >= CV_GU, item = q - up * CV_GU; const float* W = (up ? F.w_up : F.w_gate) + (size_t)le * DM * FF; const float* gk = F.norm_ffn + (size_t)(le / NE) * DM;
            if (GU8) tr_item8(W, DM, FF, (unsigned char*)F.WGU + (size_t)le * 2 * FF * DM, 1 + up, gk, SC_WGU, scr, item, F.lane);
            else tr_item(W, DM, FF, F.WGU + (size_t)le * 2 * FF * DM, 1 + up, gk, scr, item, F.lane); }
        else { const int item = q - 2 * CV_GU;
            if (DN8) tr_item8(F.w_down + (size_t)le * FF * DM, FF, DM, (unsigned char*)F.WDN + (size_t)le * DM * FF, 0, nullptr, SC_WDN, scr, item, F.lane);
            else tr_item(F.w_down + (size_t)le * FF * DM, FF, DM, F.WDN + (size_t)le * DM * FF, 0, nullptr, scr, item, F.lane); }
    }
}
__device__ __forceinline__ void p0_prologue(Frame& F, int part) {
    LAS float* scr = (LAS float*)(F.lds + F.wave * CSCR_BYTES);
    const int gw = F.vcu * NWAVES + F.wave, NGW = F.G * NWAVES;
    if (part == 1) { for (int it = 2 * CV_SMALL + gw; it < NITEMS - N_DEFER - N_OPP; it += NGW) conv_item(F, it, scr); return; }
    for (int it = gw; it < 2 * CV_SMALL; it += NGW) conv_item(F, it, scr);
    for (int m = gw; m < NB * MEMT; m += NGW) rms_row_to_bf16(F.mem + (size_t)m * DM, F.mem_norm, F.MEMN + (size_t)m * DM, F.lane);
    for (int m = gw; m < T; m += NGW) {
        const GAS f32x4* xr = (const GAS f32x4*)(F.x + (size_t)m * DM) + F.lane; f32x4 v[4]; float ss = 0.f;
#pragma unroll
        for (int j = 0; j < 4; ++j) { v[j] = __builtin_nontemporal_load(xr + 64 * j); ss += (v[j].x * v[j].x + v[j].y * v[j].y) + (v[j].z * v[j].z + v[j].w * v[j].w); }
        GAS unsigned long long* o8 = (GAS unsigned long long*)(F.XB + (size_t)m * DM) + F.lane;
#pragma unroll
        for (int j = 0; j < 4; ++j) o8[64 * j] = (unsigned long long)pk2(v[j].x, v[j].y) | ((unsigned long long)pk2(v[j].z, v[j].w) << 32);
        const float r = 1.0f / sqrtf(wave_sum(ss) * (1.f / DM) + RMS_EPS);
        if (F.lane == 0) F.RS0[m] = r;
    }
}

__device__ __forceinline__ s16x4 vtr(LAS unsigned char* p) { typedef short v4i16_t __attribute__((ext_vector_type(4))); return __builtin_bit_cast(s16x4, __builtin_amdgcn_ds_read_tr16_b64_v4i16((LAS v4i16_t*)p)); }
constexpr int KROW = 144;
constexpr int VROW = 192;
template <bool DIL>
__device__ __forceinline__ void attn_item(const bf16* qp, long q_rs, const bf16* kp, const bf16* vp, long kv_rs, int t_lo, int t_hi, int nt_total, float c2,
                                          bf16* op, long o_rs, float* lsep, long lse_rs, LAS unsigned char* kbuf, LAS unsigned char* vbuf, int lane) {
    const int ql = lane & 31, hh = lane >> 5;
    bf16x8 qf[4];
#pragma unroll
    for (int s = 0; s < 4; ++s) qf[s] = *(const GAS bf16x8*)(qp + (long)ql * q_rs + 16 * s + 8 * hh);
    f32x16 o0, o1;
#pragma unroll
    for (int i = 0; i < 16; ++i) { o0[i] = 0.f; o1[i] = 0.f; }
    float m_run = -INFINITY, l_run = 0.f;
    const float c1 = 0.125f * LOG2E;
    const float relbase = (float)(4 * hh - ql - 64);
    const int vq = (lane & 15) >> 2;
    LAS unsigned char* vrd = vbuf + (4 * hh + vq) * VROW + ((lane >> 4) & 1) * 32 + 8 * (lane & 3);
    LAS unsigned char* vwr = vbuf + (lane >> 3) * VROW + (lane & 7) * 16;
    LAS unsigned char* kwr = kbuf + (lane >> 3) * KROW + (lane & 7) * 16;
    LAS unsigned char* krd = kbuf + ql * KROW + 16 * hh;
    const bf16* krow = kp + (long)(32 * t_lo + (lane >> 3)) * kv_rs + 8 * (lane & 7);
    const bf16* vrow = vp + (long)(32 * t_lo + (lane >> 3)) * kv_rs + 8 * (lane & 7);
    v4u kk[4], vv[4];
#pragma unroll
    for (int i4 = 0; i4 < 4; ++i4) kk[i4] = *(const GAS v4u*)(krow + (long)(8 * i4) * kv_rs);
#pragma unroll
    for (int i4 = 0; i4 < 4; ++i4) vv[i4] = *(const GAS v4u*)(vrow + (long)(8 * i4) * kv_rs);
#pragma unroll 1
    for (int TI = t_lo; TI < t_hi; ++TI) {
        krow += 32 * kv_rs; vrow += 32 * kv_rs;
#pragma unroll
        for (int i4 = 0; i4 < 4; ++i4) *(LAS v4u*)(kwr + 8 * i4 * KROW) = kk[i4];
#pragma unroll
        for (int i4 = 0; i4 < 4; ++i4) *(LAS v4u*)(vwr + 8 * i4 * VROW) = vv[i4];
        if (TI + 1 < t_hi) {
#pragma unroll
            for (int i4 = 0; i4 < 4; ++i4) kk[i4] = *(const GAS v4u*)(krow + (long)(8 * i4) * kv_rs);
#pragma unroll
            for (int i4 = 0; i4 < 4; ++i4) vv[i4] = *(const GAS v4u*)(vrow + (long)(8 * i4) * kv_rs);
        }
        bf16x8 kf[4];
#pragma unroll
        for (int ss = 0; ss < 4; ++ss) kf[ss] = *(const LAS bf16x8*)(krd + 32 * ss);
        f32x16 acc;
#pragma unroll
        for (int i = 0; i < 16; ++i) acc[i] = 0.f;
#pragma unroll
        for (int ss = 0; ss < 4; ++ss) acc = __builtin_amdgcn_mfma_f32_32x32x16_bf16(kf[ss], qf[ss], acc, 0, 0, 0);
        if (DIL) {
            const float rb = relbase + (float)(32 * TI);
            const bool edge = (TI == 0) || (TI == nt_total - 1);
#pragma unroll
            for (int i = 0; i < 16; ++i) { const float ar = __builtin_fabsf(rb + (float)((i & 3) + 8 * (i >> 2))); float v = acc[i] * c1 - c2 * ar; if (edge) v = (ar > 64.f) ? -INFINITY : v; acc[i] = v; }
        } else {
#pragma unroll
            for (int i = 0; i < 16; ++i) acc[i] *= c1;
        }
        float mx = acc[0];
#pragma unroll
        for (int i = 1; i < 16; ++i) mx = __builtin_fmaxf(mx, acc[i]);
        mx = __builtin_fmaxf(mx, __shfl_xor(mx, 32));
        const float m_new = __builtin_fmaxf(m_run, mx);
        const float alpha = __builtin_amdgcn_exp2f(m_run - m_new);
        m_run = m_new;
        float ps = 0.f;
#pragma unroll
        for (int i = 0; i < 16; ++i) { acc[i] = __builtin_amdgcn_exp2f(acc[i] - m_new); ps += acc[i]; }
        l_run = l_run * alpha + ps;
#pragma unroll
        for (int i = 0; i < 16; ++i) { o0[i] *= alpha; o1[i] *= alpha; }
#pragma unroll
        for (int sk = 0; sk < 2; ++sk) {
            v4u pw; pw.x = cvtpk_s(acc[8 * sk + 0], acc[8 * sk + 1]); pw.y = cvtpk_s(acc[8 * sk + 2], acc[8 * sk + 3]);
            pw.z = cvtpk_s(acc[8 * sk + 4], acc[8 * sk + 5]); pw.w = cvtpk_s(acc[8 * sk + 6], acc[8 * sk + 7]);
            const bf16x8 pf = __builtin_bit_cast(bf16x8, pw);
            const s16x4 a0 = vtr(vrd + (16 * sk) * VROW), a1 = vtr(vrd + (16 * sk + 8) * VROW);
            const s16x4 b0 = vtr(vrd + (16 * sk) * VROW + 64), b1 = vtr(vrd + (16 * sk + 8) * VROW + 64);
            const bf16x8 vf0 = (bf16x8){a0[0], a0[1], a0[2], a0[3], a1[0], a1[1], a1[2], a1[3]};
            const bf16x8 vf1 = (bf16x8){b0[0], b0[1], b0[2], b0[3], b1[0], b1[1], b1[2], b1[3]};
            o0 = __builtin_amdgcn_mfma_f32_32x32x16_bf16(vf0, pf, o0, 0, 0, 0);
            o1 = __builtin_amdgcn_mfma_f32_32x32x16_bf16(vf1, pf, o1, 0, 0, 0);
        }
    }
    const float l_tot = l_run + __shfl_xor(l_run, 32);
    const float inv = 1.0f / l_tot;
    LAS unsigned char* ost = kbuf + ql * KROW + 8 * hh;
#pragma unroll
    for (int g4 = 0; g4 < 4; ++g4) {
        v2u w0, w1;
        w0.x = cvtpk_s(o0[4 * g4 + 0] * inv, o0[4 * g4 + 1] * inv); w0.y = cvtpk_s(o0[4 * g4 + 2] * inv, o0[4 * g4 + 3] * inv);
        w1.x = cvtpk_s(o1[4 * g4 + 0] * inv, o1[4 * g4 + 1] * inv); w1.y = cvtpk_s(o1[4 * g4 + 2] * inv, o1[4 * g4 + 3] * inv);
        *(LAS v2u*)(ost + 16 * g4) = w0; *(LAS v2u*)(ost + 64 + 16 * g4) = w1;
    }
    if (lsep != nullptr && hh == 0) lsep[(long)ql * lse_rs] = m_run + __builtin_log2f(l_tot);
#pragma unroll
    for (int i4 = 0; i4 < 4; ++i4) { const int row = (lane >> 3) + 8 * i4; const v4u w = *(const LAS v4u*)(kbuf + row * KROW + (lane & 7) * 16);
        *(GAS v4u*)(op + (long)row * o_rs + 8 * (lane & 7)) = w; }
}
__device__ __forceinline__ void p_attn_fast(Frame& F, int l) {
    LAS unsigned char* vbuf = F.lds + F.wave * 19200; LAS unsigned char* kbuf = vbuf + 6144;
    const int b = blockIdx.x % 8, widx = (blockIdx.x / 8) * NWAVES + F.wave, nw = (F.G / 8) * NWAVES;
    constexpr int NMEM = NMH * 64, NDIL = NDH * 3 * 64;
    for (int it = widx; it < NMEM + NDIL; it += nw) {
        if (it < NMEM) {
            const int hm = it / 64, blk = it % 64; const long row0 = (long)b * SEQ + 32 * blk;
            const bf16* kp = F.KVM + (size_t)(b * MEMT) * 1024 + 512 * l + 64 * hm;
            attn_item<false>(F.H + row0 * INW + C_QM + 64 * hm, INW, kp, kp + 256, 1024, 0, 8, 8, 0.f,
                                   F.MIX + row0 * DM + 768 + 64 * hm, DM, nullptr, 0, kbuf, vbuf, F.lane);
        } else {
            const int j = it - NMEM, h = j / 192, p = (j % 192) / 64, blk = j % 64;
            const int d = (p == 0) ? 1 : (p == 1 ? 4 : 16), L = SEQ / d, nb = L / 32, r = blk / nb, n = blk % nb;
            const long rowq = (long)b * SEQ + (long)(32 * n) * d + r, rowk = (long)b * SEQ + (long)(32 * n - 64) * d + r;
            const int t_lo = (n >= 2) ? 0 : 2 - n, t_hi = (n + 3 <= nb) ? 5 : nb + 2 - n;
            const float slope = __builtin_exp2f(-8.0f * (float)(h + 1) / (float)NDH);
            attn_item<true>(F.H + rowq * INW + C_Q + 64 * h, (long)d * INW, F.H + rowk * INW + C_K + 64 * h, F.H + rowk * INW + C_V + 64 * h, (long)d * INW, t_lo, t_hi, 5, slope * (float)d * LOG2E,
                                  F.OP + ((size_t)p * T + rowq) * 384 + 64 * h, (long)d * 384, F.LSE + ((size_t)p * T + rowq) * 6 + h, (long)d * 6, kbuf, vbuf, F.lane);
        }
    }
    if (widx >= 128 && SK(1)) {
        LAS float* cscr = (LAS float*)vbuf;
        const int first = NITEMS - N_DEFER + l * N_ATTT, w0 = b * 128 + (widx - 128);
        for (int j = 0; j < ATT_TAIL; ++j) conv_item(F, first + w0 + j * 1024, cscr);
    }
}

__device__ __forceinline__ void p_merge_conv(Frame& F, int l) {
    const int gw = F.vcu * NWAVES + F.wave, NGW = F.G * NWAVES;
    const float* cw = F.conv_w + (size_t)l * 3 * CONVC;
    for (int row = gw; row < T; row += NGW) {
        const int t = row % SEQ;
        if (F.lane < 48) {
            const int c0 = F.lane * 8;
            const bf16* hr = F.H + (size_t)row * INW;
            const v4u z = (v4u){0u, 0u, 0u, 0u};
            const v4u xm = (t > 0) ? *(const GAS v4u*)(hr - INW + C_XC + c0) : z, cm = (t > 0) ? *(const GAS v4u*)(hr - INW + C_CG + c0) : z;
            const v4u x0 = *(const GAS v4u*)(hr + C_XC + c0), cc = *(const GAS v4u*)(hr + C_CG + c0), bg = *(const GAS v4u*)(hr + C_BG + c0);
            const v4u xp = (t < SEQ - 1) ? *(const GAS v4u*)(hr + INW + C_XC + c0) : z, cp = (t < SEQ - 1) ? *(const GAS v4u*)(hr + INW + C_CG + c0) : z;
            float w0[8], w1[8], w2[8];
#pragma unroll
            for (int i = 0; i < 8; ++i) { w0[i] = cw[c0 + i]; w1[i] = cw[CONVC + c0 + i]; w2[i] = cw[2 * CONVC + c0 + i]; }
            v4u o;
#pragma unroll
            for (int i = 0; i < 4; ++i) {
                const float ulo = w0[2 * i] * (bflo(cm[i]) * bflo(xm[i])) + w1[2 * i] * (bflo(cc[i]) * bflo(x0[i])) + w2[2 * i] * (bflo(cp[i]) * bflo(xp[i]));
                const float uhi = w0[2 * i + 1] * (bfhi(cm[i]) * bfhi(xm[i])) + w1[2 * i + 1] * (bfhi(cc[i]) * bfhi(x0[i])) + w2[2 * i + 1] * (bfhi(cp[i]) * bfhi(xp[i]));
                o[i] = pk2(bflo(bg[i]) * ulo, bfhi(bg[i]) * uhi);
            }
            *(GAS v4u*)(F.MIX + (size_t)row * DM + c0) = o;
            const int h = F.lane >> 3;
            const float l0 = F.LSE[((size_t)0 * T + row) * 6 + h], l1 = F.LSE[((size_t)1 * T + row) * 6 + h], l2 = F.LSE[((size_t)2 * T + row) * 6 + h];
            const float mx = __builtin_fmaxf(l0, __builtin_fmaxf(l1, l2));
            float e0 = __builtin_amdgcn_exp2f(l0 - mx), e1 = __builtin_amdgcn_exp2f(l1 - mx), e2 = __builtin_amdgcn_exp2f(l2 - mx);
            const float inv = 1.0f / (e0 + e1 + e2); e0 *= inv; e1 *= inv; e2 *= inv;
            const v4u a0 = *(const GAS v4u*)(F.OP + ((size_t)0 * T + row) * 384 + c0), a1 = *(const GAS v4u*)(F.OP + ((size_t)1 * T + row) * 384 + c0), a2 = *(const GAS v4u*)(F.OP + ((size_t)2 * T + row) * 384 + c0);
            v4u od;
#pragma unroll
            for (int i = 0; i < 4; ++i) od[i] = pk2(e0 * bflo(a0[i]) + e1 * bflo(a1[i]) + e2 * bflo(a2[i]), e0 * bfhi(a0[i]) + e1 * bfhi(a1[i]) + e2 * bfhi(a2[i]));
            *(GAS v4u*)(F.MIX + (size_t)row * DM + 384 + c0) = od;
        }
    }
}

__device__ __forceinline__ void p_norm_router(Frame& F, int l) {
    LAS float* wl = (LAS float*)F.lds;
    const float* wr = F.w_router + (size_t)l * DM * NE;
    const float* g = F.norm_ffn + (size_t)l * DM;
    { f32x4 wv[8]; float gv[8];
#pragma unroll
      for (int k = 0; k < 8; ++k) { const int i4 = F.tid + 512 * k; wv[k] = *(const GAS f32x4*)(wr + 4 * i4); gv[k] = g[i4 >> 2]; }
#pragma unroll
      for (int k = 0; k < 8; ++k) { const int i4 = F.tid + 512 * k, d = i4 >> 2, e0 = (i4 & 3) * 4;
          wl[(e0 + 0) * DM + d] = wv[k].x * gv[k]; wl[(e0 + 1) * DM + d] = wv[k].y * gv[k]; wl[(e0 + 2) * DM + d] = wv[k].z * gv[k]; wl[(e0 + 3) * DM + d] = wv[k].w * gv[k]; } }
    __syncthreads();
    const int gw = F.vcu * NWAVES + F.wave, NGW = F.G * NWAVES;
    const bool b5 = (F.lane & 32) != 0, b4 = (F.lane & 16) != 0, b3 = (F.lane & 8) != 0, b2 = (F.lane & 4) != 0, b1 = (F.lane & 2) != 0;
    v2u vn[2][4];
    if (gw < T / 2) {
#pragma unroll
        for (int r = 0; r < 2; ++r) { const GAS v2u* xr = (const GAS v2u*)(F.X1B + (size_t)(2 * gw + r) * DM) + F.lane;
#pragma unroll
            for (int j = 0; j < 4; ++j) vn[r][j] = xr[64 * j]; }
    }
    for (int pr = gw; pr < T / 2; pr += NGW) {
        const int row0 = 2 * pr;
        f32x4 v[2][4];
#pragma unroll
        for (int r = 0; r < 2; ++r)
#pragma unroll
            for (int j = 0; j < 4; ++j) { v[r][j].x = bflo(vn[r][j].x); v[r][j].y = bfhi(vn[r][j].x); v[r][j].z = bflo(vn[r][j].y); v[r][j].w = bfhi(vn[r][j].y); }
        float ssum[2];
#pragma unroll
        for (int r = 0; r < 2; ++r) { const GAS f32x4* sp = (const GAS f32x4*)(F.SS1 + (size_t)(row0 + r) * 16); const f32x4 p0 = sp[0], p1 = sp[1], p2 = sp[2], p3 = sp[3];
            ssum[r] = ((((p0.x + p0.y) + (p0.z + p0.w)) + ((p1.x + p1.y) + (p1.z + p1.w))) + (((p2.x + p2.y) + (p2.z + p2.w)) + ((p3.x + p3.y) + (p3.z + p3.w)))); }
        const float r0 = 1.0f / sqrtf(ssum[0] * (1.f / DM) + RMS_EPS), r1 = 1.0f / sqrtf(ssum[1] * (1.f / DM) + RMS_EPS);
        if (pr + NGW < T / 2) {
#pragma unroll
            for (int r = 0; r < 2; ++r) { const GAS v2u* xr = (const GAS v2u*)(F.X1B + (size_t)(2 * (pr + NGW) + r) * DM) + F.lane;
#pragma unroll
                for (int j = 0; j < 4; ++j) vn[r][j] = xr[64 * j]; }
        }
        float lg[32];
        LAS float* wlp = wl + 4 * F.lane; asm volatile("" : "+v"(wlp));
#pragma unroll
        for (int e = 0; e < NE; ++e) { float a0 = 0.f, a1 = 0.f;
#pragma unroll
            for (int j = 0; j < 4; ++j) { const f32x4 w = *(const LAS f32x4*)(wlp + e * DM + 256 * j);
                a0 = __builtin_fmaf(v[0][j].x, w.x, a0); a0 = __builtin_fmaf(v[0][j].y, w.y, a0); a0 = __builtin_fmaf(v[0][j].z, w.z, a0); a0 = __builtin_fmaf(v[0][j].w, w.w, a0);
                a1 = __builtin_fmaf(v[1][j].x, w.x, a1); a1 = __builtin_fmaf(v[1][j].y, w.y, a1); a1 = __builtin_fmaf(v[1][j].z, w.z, a1); a1 = __builtin_fmaf(v[1][j].w, w.w, a1); }
            asm volatile("" : "+v"(wlp), "+v"(a0), "+v"(a1)); lg[e] = a0; lg[16 + e] = a1; }
        if (F.lane == 0) { F.RS1[row0] = r0; F.RS1[row0 + 1] = r1; }
#pragma unroll
        for (int k = 0; k < 16; ++k) { const float keep = b5 ? lg[16 + k] : lg[k], send = b5 ? lg[k] : lg[16 + k]; lg[k] = keep + __shfl_xor(send, 32); }
#pragma unroll
        for (int k = 0; k < 8; ++k) { const float keep = b4 ? lg[8 + k] : lg[k], send = b4 ? lg[k] : lg[8 + k]; lg[k] = keep + __shfl_xor(send, 16); }
#pragma unroll
        for (int k = 0; k < 4; ++k) { const float keep = b3 ? lg[4 + k] : lg[k], send = b3 ? lg[k] : lg[4 + k]; lg[k] = keep + __shfl_xor(send, 8); }
#pragma unroll
        for (int k = 0; k < 2; ++k) { const float keep = b2 ? lg[2 + k] : lg[k], send = b2 ? lg[k] : lg[2 + k]; lg[k] = keep + __shfl_xor(send, 4); }
        { const float keep = b1 ? lg[1] : lg[0], send = b1 ? lg[0] : lg[1]; lg[0] = keep + __shfl_xor(send, 2); }
        float lgt = (lg[0] + __shfl_xor(lg[0], 1)) * (b5 ? r1 : r0);
        float mx = lgt;
#pragma unroll
        for (int m = 2; m <= 16; m <<= 1) mx = __builtin_fmaxf(mx, __shfl_xor(mx, m));
        const float ex = __expf(lgt - mx); float sum = ex;
#pragma unroll
        for (int m = 2; m <= 16; m <<= 1) sum += __shfl_xor(sum, m);
        const int e = (b4 ? 8 : 0) + (b3 ? 4 : 0) + (b2 ? 2 : 0) + (b1 ? 1 : 0);
        const int row = row0 + (b5 ? 1 : 0), bb = row / SEQ, t = row % SEQ;
        if ((F.lane & 1) == 0) F.AFFT[((size_t)bb * NE + e) * SEQ + t] = ex / sum;
    }
    __syncthreads();
}

constexpr int RW_RS = 2064;
__device__ __forceinline__ void p_router_mfma(Frame& F, int l) {
    LAS unsigned char* WH = F.lds; LAS unsigned char* WL = F.lds + 16 * RW_RS; LAS f32x4* XCH = (LAS f32x4*)(F.lds + 32 * RW_RS);
    const float* wr = F.w_router + (size_t)l * DM * NE;
    const float* g = F.norm_ffn + (size_t)l * DM;
    { f32x4 wa[4], wb[4]; float ga[4], gb[4];
#pragma unroll
      for (int k = 0; k < 4; ++k) { const int c = F.tid + 512 * k, dp = c >> 2, e0 = (c & 3) * 4;
          wa[k] = *(const GAS f32x4*)(wr + (size_t)(2 * dp) * NE + e0); wb[k] = *(const GAS f32x4*)(wr + (size_t)(2 * dp + 1) * NE + e0); ga[k] = g[2 * dp]; gb[k] = g[2 * dp + 1]; }
#pragma unroll
      for (int k = 0; k < 4; ++k) { const int c = F.tid + 512 * k, dp = c >> 2, e0 = (c & 3) * 4;
#pragma unroll
          for (int j = 0; j < 4; ++j) { const float va = wa[k][j] * ga[k], vb = wb[k][j] * gb[k];
              const unsigned ha = f2bf(va), hb = f2bf(vb);
              const float ra = va - __builtin_bit_cast(float, ha << 16), rb = vb - __builtin_bit_cast(float, hb << 16);
              *(LAS unsigned*)(WH + (e0 + j) * RW_RS + 4 * dp) = ha | (hb << 16);
              *(LAS unsigned*)(WL + (e0 + j) * RW_RS + 4 * dp) = f2bf(ra) | (f2bf(rb) << 16); } } }
    __syncthreads();
    int tid_ = F.tid; asm volatile("" : "+v"(tid_));
    const int lane = tid_ & 63, tile = F.wave >> 1, kh = F.wave & 1, r16 = lane & 15, kq = lane >> 4;
    for (int blk = F.vcu; blk < T / 64; blk += F.G) {
        const int row0 = blk * 64 + tile * 16;
        const bf16* xr = F.X1B + (size_t)(row0 + r16) * DM + 512 * kh + 8 * kq;
        bf16x8 af[16];
#pragma unroll
        for (int s_ = 0; s_ < 16; ++s_) af[s_] = *(const GAS bf16x8*)(xr + 32 * s_);
        float rsum; { const f32x4 pp = *(const GAS f32x4*)(F.SS1 + (size_t)(row0 + (lane >> 2)) * 16 + 4 * (lane & 3)); rsum = (pp.x + pp.y) + (pp.z + pp.w); }
        rsum += __shfl_xor(rsum, 1); rsum += __shfl_xor(rsum, 2);
        const float rrow = 1.0f / sqrtf(rsum * (1.f / DM) + RMS_EPS);
        f32x4 acc = (f32x4){0.f, 0.f, 0.f, 0.f};
        const LAS unsigned char* bh = WH + r16 * RW_RS + (512 * kh + 8 * kq) * 2; const LAS unsigned char* bl = WL + r16 * RW_RS + (512 * kh + 8 * kq) * 2;
#pragma unroll
        for (int s_ = 0; s_ < 16; ++s_) {
            const bf16x8 fh = *(const LAS bf16x8*)(bh + 64 * s_), fl = *(const LAS bf16x8*)(bl + 64 * s_);
            acc = __builtin_amdgcn_mfma_f32_16x16x32_bf16(af[s_], fh, acc, 0, 0, 0);
            acc = __builtin_amdgcn_mfma_f32_16x16x32_bf16(af[s_], fl, acc, 0, 0, 0);
        }
        if (kh == 1) XCH[tile * 64 + lane] = acc;
        __syncthreads();
        if (kh == 0) {
            acc = acc + XCH[tile * 64 + lane];
            float rs4[4];
#pragma unroll
            for (int j = 0; j < 4; ++j) rs4[j] = __shfl(rrow, 4 * (4 * kq + j));
            f32x4 aff;
#pragma unroll
            for (int j = 0; j < 4; ++j) {
                const float lg = acc[j] * rs4[j];
                float mx = lg;
#pragma unroll
                for (int m = 1; m <= 8; m <<= 1) mx = __builtin_fmaxf(mx, __shfl_xor(mx, m));
                const float ex = __expf(lg - mx); float sm = ex;
#pragma unroll
                for (int m = 1; m <= 8; m <<= 1) sm += __shfl_xor(sm, m);
                aff[j] = ex / sm;
            }
            const int rowa = row0 + 4 * kq, bb = rowa / SEQ, t = rowa % SEQ;
            *(GAS f32x4*)(F.AFFT + ((size_t)bb * NE + r16) * SEQ + t) = aff;
            if (r16 == 0) *(GAS f32x4*)(F.RS1 + rowa) = (f32x4){rs4[0], rs4[1], rs4[2], rs4[3]};
        }
        __syncthreads();
    }
}

__device__ __forceinline__ void p_topk_pair(Frame& F, int b, int e, LAS int* lidx, LAS float* lrs, bool writer) {
    LAS unsigned* cnt = (LAS unsigned*)F.lds;
    LAS unsigned* tab = (LAS unsigned*)(F.lds + 256);
    {
        const float* src = F.AFFT + (size_t)(b * NE + e) * SEQ;
        unsigned x[4];
#pragma unroll
        for (int i = 0; i < 4; ++i) x[i] = __builtin_bit_cast(unsigned, src[i * 512 + F.tid]);
        float rs1v[4];
#pragma unroll
        for (int i = 0; i < 4; ++i) rs1v[i] = F.RS1[(size_t)b * SEQ + i * 512 + F.tid];
        unsigned prefix = 0u;
#pragma unroll 1
        for (int ps = 0; ps < 16; ++ps) {
            const int sh = 30 - 2 * ps;
            const unsigned c1 = prefix | (1u << sh), c2 = prefix | (2u << sh), c3 = prefix | (3u << sh);
            unsigned n1 = 0u, n2 = 0u, n3 = 0u;
#pragma unroll
            for (int i = 0; i < 4; ++i) { n1 += (unsigned)__builtin_popcountll(__ballot(x[i] >= c1)); n2 += (unsigned)__builtin_popcountll(__ballot(x[i] >= c2)); n3 += (unsigned)__builtin_popcountll(__ballot(x[i] >= c3)); }
            const int par = (ps & 1) * 24;
            if (F.lane == 0) { cnt[par + F.wave] = n1; cnt[par + 8 + F.wave] = n2; cnt[par + 16 + F.wave] = n3; }
            __syncthreads();
            unsigned t1 = 0u, t2 = 0u, t3 = 0u;
#pragma unroll
            for (int w = 0; w < 8; ++w) { t1 += cnt[par + w]; t2 += cnt[par + 8 + w]; t3 += cnt[par + 16 + w]; }
            if (t3 >= (unsigned)CAP) prefix = c3; else if (t2 >= (unsigned)CAP) prefix = c2; else if (t1 >= (unsigned)CAP) prefix = c1;
        }
        unsigned long long bq[4], bs[4];
#pragma unroll
        for (int i = 0; i < 4; ++i) { const unsigned long long bg = __ballot(x[i] > prefix); bq[i] = __ballot(x[i] == prefix);
            if (F.lane == 0) { tab[i * 8 + F.wave] = (unsigned)__builtin_popcountll(bg); tab[32 + i * 8 + F.wave] = (unsigned)__builtin_popcountll(bq[i]); } }
        __syncthreads();
        unsigned gtot = 0u;
#pragma unroll
        for (int j = 0; j < 32; ++j) gtot += tab[j];
        const unsigned need = (unsigned)CAP - gtot;
        unsigned run = 0u, eqb[4];
#pragma unroll
        for (int j = 0; j < 32; ++j) { const unsigned v = tab[32 + j];
#pragma unroll
            for (int i = 0; i < 4; ++i) if (j == i * 8 + F.wave) eqb[i] = run;
            run += v; }
        bool sel[4];
#pragma unroll
        for (int i = 0; i < 4; ++i) {
            const unsigned rk = eqb[i] + __builtin_amdgcn_mbcnt_hi((unsigned)(bq[i] >> 32), __builtin_amdgcn_mbcnt_lo((unsigned)bq[i], 0u));
            sel[i] = (x[i] > prefix) || (x[i] == prefix && rk < need);
            bs[i] = __ballot(sel[i]);
            if (F.lane == 0) tab[64 + i * 8 + F.wave] = (unsigned)__builtin_popcountll(bs[i]);
        }
        __syncthreads();
        run = 0u; unsigned selb[4];
#pragma unroll
        for (int j = 0; j < 32; ++j) { const unsigned v = tab[64 + j];
#pragma unroll
            for (int i = 0; i < 4; ++i) if (j == i * 8 + F.wave) selb[i] = run;
            run += v; }
#pragma unroll
        for (int i = 0; i < 4; ++i) {
            const int t = i * 512 + F.tid, row = b * SEQ + t;
            const unsigned slot = selb[i] + __builtin_amdgcn_mbcnt_hi((unsigned)(bs[i] >> 32), __builtin_amdgcn_mbcnt_lo((unsigned)bs[i], 0u));
            if (sel[i]) { lidx[slot] = row; lrs[slot] = rs1v[i] * (GU8 ? 1.f / (SC_X1 * SC_WGU) : 1.f); if (writer) F.GROW[(size_t)e * ER + b * CAP + slot] = __builtin_bit_cast(float, x[i]) * ((DN8 ? 1.f / (SC_HID * SC_WDN) : 1.f) * (Y8 ? SC_Y : 1.f)); }
            if (writer) F.INV[(size_t)row * NE + e] = (short)(sel[i] ? (int)slot : -1);
        }
        __syncthreads();
    }
}

template <bool YF8>
__device__ __forceinline__ void p_combine_norm(Frame& F, int l) {
    const int gw = F.vcu * NWAVES + F.wave, NGW = F.G * NWAVES;
    const bf16* Y = F.XG;
    const GAS f32x4* gr = (const GAS f32x4*)F.norm_final + F.lane;
    for (int pr = gw; pr < T / 2; pr += NGW) {
        typedef float f32x2 __attribute__((ext_vector_type(2)));
        v2u xv[2][4]; typename std::conditional<YF8, unsigned, v2u>::type yv[2][4][4]; float ysc[2][4]; unsigned rest[2]; int invr[2];
#pragma unroll
        for (int q = 0; q < 2; ++q) {
            const int row = pr + q * (T / 2), b = row / SEQ;
            const GAS v2u* xr = (const GAS v2u*)(F.X1B + (size_t)row * DM) + F.lane;
#pragma unroll
            for (int j = 0; j < 4; ++j) xv[q][j] = xr[64 * j];
            invr[q] = (int)F.INV[(size_t)row * NE + (F.lane & 15)];
            unsigned m = (unsigned)__ballot(invr[q] >= 0) & 0xffffu;
#pragma unroll
            for (int k = 0; k < 4; ++k) {
                const bool has = m != 0u; const int e = has ? __builtin_ctz(m) : 0; m &= m - 1u;
                const int r = has ? __builtin_amdgcn_readlane(invr[q], e) : 0;
                ysc[q][k] = has ? (YF8 ? 1.f / SC_Y : 1.f) : 0.f;
                if constexpr (YF8) { const GAS unsigned* yr = (const GAS unsigned*)((const unsigned char*)Y + ((size_t)e * ER + b * CAP + r) * DM) + F.lane;
#pragma unroll
                    for (int j = 0; j < 4; ++j) yv[q][k][j] = yr[64 * j]; }
                else { const GAS v2u* yr = (const GAS v2u*)(Y + ((size_t)e * ER + b * CAP + r) * DM) + F.lane;
#pragma unroll
                    for (int j = 0; j < 4; ++j) yv[q][k][j] = yr[64 * j]; }
            }
            rest[q] = m;
        }
#pragma unroll
        for (int q = 0; q < 2; ++q) {
            const int row = pr + q * (T / 2), b = row / SEQ;
            f32x4 v[4];
#pragma unroll
            for (int j = 0; j < 4; ++j) { v[j].x = bflo(xv[q][j].x); v[j].y = bfhi(xv[q][j].x); v[j].z = bflo(xv[q][j].y); v[j].w = bfhi(xv[q][j].y); }
#pragma unroll
            for (int k = 0; k < 4; ++k)
#pragma unroll
                for (int j = 0; j < 4; ++j) { const float sc = ysc[q][k];
                    if constexpr (YF8) { const unsigned w = yv[q][k][j]; const f32x2 lo = __builtin_amdgcn_cvt_pk_f32_fp8((int)w, false), hi = __builtin_amdgcn_cvt_pk_f32_fp8((int)w, true);
                        v[j].x += sc * lo.x; v[j].y += sc * lo.y; v[j].z += sc * hi.x; v[j].w += sc * hi.y; }
                    else { const v2u w = yv[q][k][j]; v[j].x += sc * bflo(w.x); v[j].y += sc * bfhi(w.x); v[j].z += sc * bflo(w.y); v[j].w += sc * bfhi(w.y); } }
            unsigned m = rest[q];
            while (m != 0u) {
                const int e = __builtin_ctz(m); m &= m - 1u; const int r = __builtin_amdgcn_readlane(invr[q], e);
                if constexpr (YF8) { const GAS unsigned* yr = (const GAS unsigned*)((const unsigned char*)Y + ((size_t)e * ER + b * CAP + r) * DM) + F.lane;
#pragma unroll
                    for (int j = 0; j < 4; ++j) { const unsigned w = yr[64 * j]; const f32x2 lo = __builtin_amdgcn_cvt_pk_f32_fp8((int)w, false), hi = __builtin_amdgcn_cvt_pk_f32_fp8((int)w, true);
                        v[j].x += (1.f / SC_Y) * lo.x; v[j].y += (1.f / SC_Y) * lo.y; v[j].z += (1.f / SC_Y) * hi.x; v[j].w += (1.f / SC_Y) * hi.y; } }
                else { const GAS v2u* yr = (const GAS v2u*)(Y + ((size_t)e * ER + b * CAP + r) * DM) + F.lane;
#pragma unroll
                for (int j = 0; j < 4; ++j) { const v2u w = yr[64 * j]; v[j].x += bflo(w.x); v[j].y += bfhi(w.x); v[j].z += bflo(w.y); v[j].w += bfhi(w.y); } }
            }
            float s = 0.f;
#pragma unroll
            for (int j = 0; j < 4; ++j) s += (v[j].x * v[j].x + v[j].y * v[j].y) + (v[j].z * v[j].z + v[j].w * v[j].w);
            const float rr = 1.0f / sqrtf(wave_sum(s) * (1.f / DM) + RMS_EPS);
            if (l + 1 < NLAYER) {
                GAS unsigned long long* o8 = (GAS unsigned long long*)(F.XB + (size_t)row * DM) + F.lane;
#pragma unroll
                for (int j = 0; j < 4; ++j) o8[64 * j] = (unsigned long long)pk2(v[j].x, v[j].y) | ((unsigned long long)pk2(v[j].z, v[j].w) << 32);
                if (F.lane == 0) F.RS0[row] = rr;
            } else {
                GAS f32x4* orow = (GAS f32x4*)(F.out + (size_t)row * DM) + F.lane;
#pragma unroll
                for (int j = 0; j < 4; ++j) __builtin_nontemporal_store(v[j] * rr * gr[64 * j], orow + 64 * j);
            }
        }
    }
}

struct Args { const float* in[14]; float* out; unsigned char* ws; int ph_lo, ph_hi, li, pad; };
constexpr int NPHASE = 1 + 9 * NLAYER;
template <class Tp> __device__ __forceinline__ Tp* as_global(Tp* p) { return (Tp*)(GAS Tp*)p; }
__device__ __forceinline__ void build_frame(Frame& F) {
    extern __shared__ __attribute__((aligned(16))) unsigned char lds[];
    const CAS Args* A = (const CAS Args*)__builtin_amdgcn_kernarg_segment_ptr();
    asm volatile("" : "+s"(A));
    int tid = threadIdx.x; asm volatile("" : "+v"(tid));
    F.lds = (LAS unsigned char*)lds;
    F.tid = tid; F.lane = tid & 63; F.wave = __builtin_amdgcn_readfirstlane(tid >> 6);
    F.G = gridDim.x; { const int bx = blockIdx.x; F.vcu = (F.G % 8 == 0) ? (bx % 8) * (F.G / 8) + bx / 8 : bx; }
    unsigned char* ws = as_global(A->ws);
    F.x = as_global(A->in[0]); F.mem = as_global(A->in[1]); F.mem_norm = as_global(A->in[2]); F.norm_mix = as_global(A->in[3]); F.w_in = as_global(A->in[4]); F.conv_w = as_global(A->in[5]); F.w_mem_kv = as_global(A->in[6]);
    F.w_out = as_global(A->in[7]); F.norm_ffn = as_global(A->in[8]); F.w_router = as_global(A->in[9]); F.w_gate = as_global(A->in[10]); F.w_up = as_global(A->in[11]); F.w_down = as_global(A->in[12]); F.norm_final = as_global(A->in[13]);
    F.out = as_global(A->out);
    F.WIN = (bf16*)(ws + WS_WIN); F.WKV = (bf16*)(ws + WS_WKV); F.WOUT = (bf16*)(ws + WS_WOUT); F.WGU = (bf16*)(ws + WS_WGU); F.WDN = (bf16*)(ws + WS_WDN);
    F.XB = (bf16*)(ws + WS_XB); F.X1B = (bf16*)(ws + WS_X1B); F.H = (bf16*)(ws + WS_H); F.OP = (bf16*)(ws + WS_OP); F.MIX = (bf16*)(ws + WS_MIX); F.MEMN = (bf16*)(ws + WS_MEMN); F.KVM = (bf16*)(ws + WS_KVM);
    F.XG = (bf16*)(ws + WS_XG); F.HID = (bf16*)(ws + WS_HID); F.LSE = (float*)(ws + WS_LSE); F.AFFT = (float*)(ws + WS_AFFT); F.GROW = (float*)(ws + WS_GROW); F.INV = (short*)(ws + WS_INV); F.IDX = (int*)(ws + WS_IDX); F.RS0 = (float*)(ws + WS_RS0); F.SS1 = (float*)(ws + WS_SS1); F.RS1 = (float*)(ws + WS_RS1); F.RSLOT = (float*)(ws + WS_RSLOT); F.X1F8 = ws + WS_X1F8;
}
__device__ __forceinline__ void opp_round() {
    Frame F; build_frame(F);
    volatile LAS unsigned* rd = (volatile LAS unsigned*)(F.lds + MISC_OFF) + 24;
    const unsigned r = rd[0];
    conv_item(F, NITEMS - N_DEFER - N_OPP + (int)r * (256 * NWAVES) + F.vcu * NWAVES + F.wave, (LAS float*)(F.lds + F.wave * CSCR_BYTES));
    __syncthreads();
    if (F.tid == 0) rd[0] = r + 1u;
    __syncthreads();
}
__device__ __forceinline__ void seam_barrier(int k) {
    extern __shared__ __attribute__((aligned(16))) unsigned char lds[];
    const CAS Args* A = (const CAS Args*)__builtin_amdgcn_kernarg_segment_ptr();
    asm volatile("" : "+s"(A));
    XcdBarrier b;
#if ONE_LAUNCH
    b.bar = as_global((unsigned*)g_barrier_words);
#else
    b.bar = (unsigned*)(as_global(A->ws) + WS_CTL) + CW_BAR + A->li * XCD_BAR_WORDS;
#endif
    b.x = xb_xcc_id(); b.st = (volatile LAS unsigned*)((LAS unsigned char*)lds + MISC_OFF) + 8;
    const bool opp = (k <= OPP_LAST_PHASE) && (b.st[16] < (unsigned)OPP_ROUNDS);
    xcd_barrier(b, opp);
    if (opp && b.st[2] != 0u) { opp_round(); xcd_barrier_wait(b); }
}
__global__ void __launch_bounds__(NWAVES * 64, 2) mega_fwd(Args args) {
    extern __shared__ __attribute__((aligned(16))) unsigned char lds[];
    for (int u = threadIdx.x; u < (LDS_BYTES - LDSCTL_OFF) / 4; u += NWAVES * 64) ((LAS unsigned*)((LAS unsigned char*)lds + LDSCTL_OFF))[u] = 0u;
    __syncthreads();
    const int lo = args.ph_lo, hi = args.ph_hi;
#if ONE_LAUNCH
    if (hi - lo > 1) (void)xcd_barrier_post(as_global((unsigned*)g_barrier_words), (volatile LAS unsigned*)((LAS unsigned char*)lds + MISC_OFF) + 8);
#else
    if (hi - lo > 1) (void)xcd_barrier_post((unsigned*)(args.ws + WS_CTL) + CW_BAR + args.li * XCD_BAR_WORDS, (volatile LAS unsigned*)((LAS unsigned char*)lds + MISC_OFF) + 8);
#endif
#define IN(k) (lo <= (k) && (k) < hi)
#define SEAM(k) do { if ((k) + 1 < hi) for (int rep = 0; rep < NREP(2048); ++rep) seam_barrier(k); } while (0)

    if (IN(0)) { if (SK(1)) for (int rep = 0; rep < NREP(1); ++rep) { Frame F; build_frame(F); p0_prologue(F, 0); } SEAM(0);
                 if (SK(1)) for (int rep = 0; rep < NREP(1); ++rep) { Frame F; build_frame(F); p0_prologue(F, 1); } __syncthreads(); }
#pragma unroll 1
    for (int l = 0; l < NLAYER; ++l) {
        const int pb = 1 + 9 * l;
        if (IN(pb + 0)) {
            if (SK(2)) for (int rep = 0; rep < NREP(2); ++rep) { Frame F; build_frame(F);
              pg8::Gemm g{F.XB, F.WIN + (size_t)l * INW * DM, T, INW, DM, 1 << 30, 0, nullptr}; pg8::StaticOrder S; S.init(T, INW, F.G, (int)blockIdx.x);
              pg8::EpiBf16 E{F.H, INW, F.RS0};
              pg8::gemm_phase<pg8::EpiBf16, pg8::StaticOrder, true, true>(F.lds, g, S, E); }
            if (SK(4) && l == 0) { Frame F; build_frame(F);
              pg8::Gemm g{F.MEMN, F.WKV, NB * MEMT, 1024, DM, 1 << 30, 0, nullptr}; pg8::StaticOrder S; S.init(NB * MEMT, 1024, F.G, (int)((blockIdx.x + F.G / 2) % F.G));
              pg8::EpiBf16 E{F.KVM, 1024, nullptr};
              pg8::gemm_phase<pg8::EpiBf16, pg8::StaticOrder, true, true>(F.lds, g, S, E); }
            { const int wg0 = (l == 0) ? DEFER_WG0 : DEFER_WG1, first = (l == 0) ? NITEMS - N_DEFER0 : NITEMS - N_DEFER0 - N_DEFER1;
              if (SK(1) && (int)blockIdx.x >= wg0) { Frame F; build_frame(F);
                LAS float* scr = (LAS float*)(F.lds + F.wave * CSCR_BYTES); const int w0 = ((int)blockIdx.x - wg0) * NWAVES + F.wave;
                for (int j = 0; j < DEFER_PER; ++j) conv_item(F, first + w0 + j * (256 - wg0) * NWAVES, scr); } }
            SEAM(pb + 0);
        }
        if (IN(pb + 1)) { if (SK(8)) for (int rep = 0; rep < NREP(8); ++rep) { Frame F; build_frame(F); p_attn_fast(F, l); } SEAM(pb + 1); }
        if (IN(pb + 2)) { if (SK(16)) for (int rep = 0; rep < NREP(16); ++rep) { Frame F; build_frame(F); p_merge_conv(F, l); } SEAM(pb + 2); }
        if (IN(pb + 3)) {
            if (SK(32)) for (int rep = 0; rep < NREP(32); ++rep) { Frame F; build_frame(F);
            pg8::Gemm g{F.MIX, F.WOUT + (size_t)l * DM * DM, T, DM, DM, 1 << 30, 0, nullptr}; pg8::StaticOrder S; S.init(T, DM, F.G, (int)blockIdx.x);
            pg8::EpiResBf16 E{F.XB, F.X1B, DM, F.SS1, GU8 ? F.X1F8 : nullptr, SC_X1};
            pg8::gemm_phase<pg8::EpiResBf16, pg8::StaticOrder, false, true>(F.lds, g, S, E); }
            SEAM(pb + 3);
        }
        if (IN(pb + 4)) { if (SK(64)) for (int rep = 0; rep < NREP(64); ++rep) { Frame F; build_frame(F); if (ROUTER_MFMA) p_router_mfma(F, l); else p_norm_router(F, l); }
            if (l == NLAYER - 1 && SK(1)) { __syncthreads(); while (((volatile LAS unsigned*)((LAS unsigned char*)lds + MISC_OFF))[24] < (unsigned)OPP_ROUNDS) opp_round(); }
            SEAM(pb + 4); }
        if (IN(pb + 6)) {
            if (SK(256)) for (int rep = 0; rep < NREP(256); ++rep) { Frame F; build_frame(F);
            const int e = F.vcu >> 4, b = F.vcu & 7, pm = e * 8 + b;
            LAS int* lidx = (LAS int*)(F.lds + LDSX_OFF); LAS float* lrs = (LAS float*)(F.lds + LDSX_OFF + 1024);
            p_topk_pair(F, b, e, lidx, lrs, ((F.vcu >> 3) & 1) == 0);
            pg8::ExpertOrder S; S.init(F.vcu);
            static_assert(GU8 == DN8, "expert GEMMs: both fp8 or both bf16");
            static_assert(N_DEFER + N_OPP <= NE * CV_LE, "deferred and pool items are layer 1 expert weights");
            if constexpr (GU8) {
              pg8::Gemm g{(const pg8::bf16_t*)F.X1F8, (const pg8::bf16_t*)((const unsigned char*)F.WGU + (size_t)l * NE * 2 * FF * DM), NE * ER, 2 * FF, DM / 2, ER / 256, (size_t)2 * FF * DM / 2, (const int*)lidx - pm * 256};
              pg8::EpiSwiGLU8 E{(unsigned char*)F.HID, FF, (const float*)lrs - pm * 256, SC_HID};
              pg8::gemm_phase<pg8::EpiSwiGLU8, pg8::ExpertOrder, true, true, true, true>(F.lds, g, S, E); }
            else { pg8::Gemm g{F.X1B, F.WGU + (size_t)l * NE * 2 * FF * DM, NE * ER, 2 * FF, DM, ER / 256, (size_t)2 * FF * DM, (const int*)lidx - pm * 256};
              pg8::EpiSwiGLU E{F.HID, FF, (const float*)lrs - pm * 256};
              pg8::gemm_phase<pg8::EpiSwiGLU, pg8::ExpertOrder, true, true, true>(F.lds, g, S, E); } }
            SEAM(pb + 6);
        }
        if (IN(pb + 7)) {
            if (SK(512)) for (int rep = 0; rep < NREP(512); ++rep) { Frame F; build_frame(F);
            pg8::StaticOrder S; S.init(NE * ER, DM, F.G, (int)blockIdx.x); pg8::EpiBf16 E{F.XG, DM, F.GROW};
            static_assert(!Y8 || DN8, "fp8 Y needs the fp8 down projection");
            if constexpr (DN8) {
              pg8::Gemm g{F.HID, (const pg8::bf16_t*)((const unsigned char*)F.WDN + (size_t)l * NE * DM * FF), NE * ER, DM, FF / 2, ER / 256, (size_t)DM * FF / 2, nullptr};
              if constexpr (Y8) { pg8::EpiF8 E8{(unsigned char*)F.XG, DM, F.GROW}; pg8::gemm_phase<pg8::EpiF8, pg8::StaticOrder, true, true, false, true>(F.lds, g, S, E8); }
              else pg8::gemm_phase<pg8::EpiBf16, pg8::StaticOrder, true, true, false, true>(F.lds, g, S, E); }
            else { pg8::Gemm g{F.HID, F.WDN + (size_t)l * NE * DM * FF, NE * ER, DM, FF, ER / 256, (size_t)DM * FF, nullptr};
              pg8::gemm_phase<pg8::EpiBf16, pg8::StaticOrder, true, true>(F.lds, g, S, E); } }
            SEAM(pb + 7);
        }
        if (IN(pb + 8)) { if (SK(1024)) for (int rep = 0; rep < NREP(1024); ++rep) { Frame F; build_frame(F); p_combine_norm<Y8>(F, l); } SEAM(pb + 8); }
    }
#undef IN
#undef SEAM
#if ONE_LAUNCH
    if (hi - lo > 1) {
        __syncthreads();
        if (threadIdx.x == 0) { unsigned* bar = as_global((unsigned*)g_barrier_words);
            if (xb_add(&bar[XB_EXIT], 1u) + 1u == gridDim.x) {
                for (unsigned j = 0; j < 16; ++j) { __hip_atomic_store(&bar[XB_XCNT(j)], 0u, RLX_AGENT); __hip_atomic_store(&bar[XB_XSUB(j)], 0u, RLX_AGENT); __hip_atomic_store(&bar[XB_XGEN(j)], 0u, RLX_AGENT); }
                __hip_atomic_store(&bar[XB_TOP], 0u, RLX_AGENT); __hip_atomic_store(&bar[XB_TOPGEN], 0u, RLX_AGENT); __hip_atomic_store(&bar[XB_TMO], 0u, RLX_AGENT); __hip_atomic_store(&bar[XB_EXIT], 0u, RLX_AGENT); } }
    }
#endif
}

extern "C" void kernel_launch(void* const* d_in, const int* in_sizes, int n_in, void* d_out, int out_size, void* d_ws, size_t ws_size, hipStream_t stream) {
    static int grid = 0;
    if (grid == 0) {
        if (n_in != 14 || in_sizes[0] != T * DM || out_size != T * DM || ws_size < WS_END) { fprintf(stderr, "kernel_launch: unexpected shapes (n_in %d, in0 %d, out %d, ws %zu); nothing launched\n", n_in, n_in > 0 ? in_sizes[0] : -1, out_size, ws_size); grid = -1; return; }
        int dev = 0, cus = 0;
        if (hipGetDevice(&dev) != hipSuccess || hipDeviceGetAttribute(&cus, hipDeviceAttributeMultiprocessorCount, dev) != hipSuccess) { grid = -1; return; }
        if (hipFuncSetAttribute((const void*)mega_fwd, hipFuncAttributeMaxDynamicSharedMemorySize, LDS_BYTES) != hipSuccess) { fprintf(stderr, "kernel_launch: hipFuncSetAttribute failed\n"); grid = -1; return; }
        (void)hipGetLastError();
        grid = cus;
        if (grid != 256) fprintf(stderr, "kernel_launch: %d CUs; this kernel is laid out for 256\n", grid);
    }
    if (grid < 0) return;
#if !ONE_LAUNCH
    (void)hipMemsetAsync((char*)d_ws + WS_CTL, 0, CTL_ZERO_BYTES, stream);
#endif
    Args a{};
    for (int i = 0; i < 14; ++i) a.in[i] = (const float*)d_in[i];
    a.out = (float*)d_out; a.ws = (unsigned char*)d_ws;
    int li = 0;
    auto mega = [&](int lo, int hi) { a.ph_lo = lo; a.ph_hi = hi; a.li = li++; hipLaunchKernelGGL(mega_fwd, dim3(grid), dim3(NWAVES * 64), LDS_BYTES, stream, a); };
#if ONE_LAUNCH
    mega(0, NPHASE);
#else
    for (int k = 0; k < NPHASE; ++k) mega(k, k + 1);
#endif
}
```

```cpp
#include <hip/hip_runtime.h>
#include <cstdio>
#include <cstdint>
#include <cmath>
#include <type_traits>

#ifndef ONE_LAUNCH
#define ONE_LAUNCH 1
#endif
#ifndef ROUTER_MFMA
#define ROUTER_MFMA 1
#endif
#ifndef SKIPMASK
#define SKIPMASK 0
#endif
#define SK(b) (!((SKIPMASK) & (b)))
#ifndef DUPMASK
#define OPP_ELIG8 8
#define CONV_DMA_AUX 2
#define DUPMASK 0
#endif
#define NREP(b) (((DUPMASK) & (b)) ? 2 : 1)

#define GAS __attribute__((address_space(1)))
#define LAS __attribute__((address_space(3)))
#define CAS __attribute__((address_space(4)))
typedef unsigned short bf16;
typedef unsigned v4u __attribute__((ext_vector_type(4)));
typedef unsigned v2u __attribute__((ext_vector_type(2)));
typedef float f32x4 __attribute__((ext_vector_type(4)));
typedef float f32x16 __attribute__((ext_vector_type(16)));
typedef short bf16x8 __attribute__((ext_vector_type(8)));
typedef short s16x4 __attribute__((ext_vector_type(4)));

constexpr int NB = 8, SEQ = 2048, DM = 1024, NLAYER = 2, MEMT = 256, INW = 2560;
constexpr int T = NB * SEQ;
constexpr int C_XC = 0, C_BG = 384, C_CG = 768, C_Q = 1152, C_K = 1536, C_V = 1920, C_QM = 2304;
constexpr int HW = 2176, H_U = 0, H_BG = 384, H_Q = 768, H_K = 1152, H_V = 1536, H_QM = 1920;
constexpr int NDH = 6, NMH = 4, CONVC = 384;
constexpr int NE = 16, FF = 2048, CAP = 256, ER = NB * CAP;
constexpr float RMS_EPS = 1e-6f;
constexpr float LOG2E = 1.4426950408889634f;

constexpr size_t MiB = 1u << 20;
constexpr size_t WS_CTL = 0, CTL_ZERO_BYTES = 1 * MiB;
constexpr size_t WS_WIN = 2 * MiB;
constexpr size_t WS_WKV = 12 * MiB;
constexpr size_t WS_WOUT = 14 * MiB;
constexpr size_t WS_WGU = 18 * MiB;
constexpr size_t WS_WDN = 274 * MiB;
constexpr size_t WS_XB = 402 * MiB;
constexpr size_t WS_H = 434 * MiB;
constexpr size_t WS_OP = 514 * MiB;
constexpr size_t WS_LSE = 550 * MiB;
constexpr size_t WS_MIX = 552 * MiB;
constexpr size_t WS_MEMN = 584 * MiB;
constexpr size_t WS_KVM = 588 * MiB;
constexpr size_t WS_AFFT = 592 * MiB;
constexpr size_t WS_INV = 593 * MiB;
constexpr size_t WS_GROW = 594 * MiB;
constexpr size_t WS_IDX = 595 * MiB;
constexpr size_t WS_XG = 596 * MiB;
constexpr size_t WS_HID = 660 * MiB;
constexpr size_t WS_X1B = 788 * MiB;
constexpr size_t WS_RS0 = 820 * MiB;
constexpr size_t WS_SS1 = 821 * MiB;
constexpr size_t WS_RS1 = 823 * MiB;
constexpr size_t WS_RSLOT = 824 * MiB;
constexpr size_t WS_X1F8 = 825 * MiB;
constexpr size_t WS_XB8 = 841 * MiB;
constexpr size_t WS_WIN8 = 857 * MiB;
constexpr size_t WS_RS0S = 860 * MiB;
constexpr size_t WS_END = 861 * MiB;

constexpr int CW_BAR = 4096;
#define XCD_BAR_WORDS 3456
constexpr int MAX_LAUNCH = 24;
static_assert((CW_BAR + MAX_LAUNCH * XCD_BAR_WORDS) * 4 <= (int)CTL_ZERO_BYTES, "ctl");

constexpr int RING_BYTES = 131072, LDSCTL_OFF = 155648  , MISC_OFF = LDSCTL_OFF + 320, LDSX_OFF = LDSCTL_OFF + 4096  , LDS_BYTES = 163840  ;
constexpr int NWAVES = 8;

#define RLX_AGENT __ATOMIC_RELAXED, __HIP_MEMORY_SCOPE_AGENT
#define LDS_WAIT() asm volatile("s_waitcnt lgkmcnt(0)" ::: "memory")
__device__ __forceinline__ unsigned f2bf(float f) { unsigned u = __builtin_bit_cast(unsigned, f); return (u + 0x7fffu + ((u >> 16) & 1u)) >> 16; }
__device__ __forceinline__ unsigned pk2(float lo, float hi) { return f2bf(lo) | (f2bf(hi) << 16); }
__device__ __forceinline__ unsigned cvtpk_s(float lo, float hi) { typedef float f2 __attribute__((ext_vector_type(2))); typedef __bf16 b2 __attribute__((ext_vector_type(2))); f2 v = {lo, hi}; b2 b = __builtin_convertvector(v, b2); return __builtin_bit_cast(unsigned, b); }
__device__ __forceinline__ float bflo(unsigned w) { return __builtin_bit_cast(float, w << 16); }
__device__ __forceinline__ float bfhi(unsigned w) { return __builtin_bit_cast(float, w & 0xffff0000u); }
__device__ __forceinline__ float bf2f(bf16 v) { return __builtin_bit_cast(float, (unsigned)v << 16); }
__device__ __forceinline__ float wave_sum(float v) {
#pragma unroll
    for (int o = 1; o < 64; o <<= 1) v += __shfl_xor(v, o);
    return v;
}

namespace pg8 {
#define PG8_LAS __attribute__((address_space(3)))
typedef unsigned short bf16_t;
typedef short bf16x8 __attribute__((ext_vector_type(8)));
typedef float f32x4 __attribute__((ext_vector_type(4)));
typedef unsigned u32x4 __attribute__((ext_vector_type(4)));
typedef unsigned u32x2 __attribute__((ext_vector_type(2)));
constexpr int BM = 256, BK = 64, HALF = 128, HTB = HALF * BK * 2  , STAGE_BYTES = 8 * HTB, NXCD = 8, WGM = 8;

__host__ __device__ __forceinline__ int lds_byte(int r, int c) { const int st = (r >> 4) * 2 + (c >> 5), rr = r & 15, cc = c & 31, ob = rr * 64 + cc * 2; return st * 1024 + (ob ^ (((ob >> 9) & 1) << 5)); }
__host__ __device__ __forceinline__ void stage_rc(int b, int& R, int& C) { const int st = b / 1024, sb = b % 1024, swz = sb ^ (((sb >> 9) & 1) << 5); R = (st >> 1) * 16 + swz / 64; C = (st & 1) * 32 + (swz % 64) / 2; }
__host__ __device__ __forceinline__ int perm32(int rho) { const int n = rho >> 4, i = rho & 15; return 8 * (i >> 2) + 4 * n + (i & 3); }

typedef int i32x4 __attribute__((ext_vector_type(4)));
typedef int i32x8 __attribute__((ext_vector_type(8)));
__device__ __forceinline__ i32x8 cat8(bf16x8 a, bf16x8 b) { const i32x4 x = __builtin_bit_cast(i32x4, a), y = __builtin_bit_cast(i32x4, b); return __builtin_shufflevector(x, y, 0, 1, 2, 3, 4, 5, 6, 7); }
__device__ __forceinline__ unsigned pk4_e4m3(float a, float b, float c, float d) {
    a = __builtin_amdgcn_fmed3f(a, -448.f, 448.f); b = __builtin_amdgcn_fmed3f(b, -448.f, 448.f); c = __builtin_amdgcn_fmed3f(c, -448.f, 448.f); d = __builtin_amdgcn_fmed3f(d, -448.f, 448.f);
    int w = __builtin_amdgcn_cvt_pk_fp8_f32(a, b, 0, false); w = __builtin_amdgcn_cvt_pk_fp8_f32(c, d, w, true); return (unsigned)w; }
__device__ __forceinline__ void mfma8(f32x4& acc, i32x8 a, i32x8 b) { asm volatile("v_mfma_f32_16x16x128_f8f6f4 %0, %1, %2, %0" : "+v"(acc) : "v"(a), "v"(b)); }
struct Unit { int pm, pn; };
struct Gemm { const bf16_t* A; const bf16_t* Bt; int M, N, K; int gm; size_t gstride; const int* aidx; };

struct StaticOrder {
    static constexpr bool PREFETCH = false; static constexpr int slice = 0;
    int nM, nN, nwg, G, c;
    __host__ __device__ void init(int M, int N, int G_, int c_) { nM = M / BM; nN = N / BM; nwg = nM * nN; G = G_; c = c_; }
    __host__ __device__ bool next(int i, Unit& u) const {
        const long L = (long)i * G + c; if (L >= nwg) return false;
        int wgid = (int)L; { const int q = nwg / NXCD, r = nwg % NXCD, xcd = wgid % NXCD, off = wgid / NXCD; wgid = (xcd < r ? xcd * (q + 1) : r * (q + 1) + (xcd - r) * q) + off; }
        const int nig = WGM * nN, gid = wgid / nig, fm = gid * WGM, gsz = (nM - fm) < WGM ? (nM - fm) : WGM;
        u.pm = fm + ((wgid % nig) % gsz); u.pn = (wgid % nig) / gsz; return true;
    }
    __device__ __forceinline__ void a_ready(const Unit&) const {}
    __device__ __forceinline__ void done(const Unit&) const {}
};

struct ExpertOrder {
    static constexpr bool PREFETCH = true;
    int pm, pn0, slice;
    __device__ __forceinline__ void init(int vcu) { pm = (vcu >> 4) * 8 + (vcu & 7); pn0 = ((vcu >> 3) & 1) * 8; slice = vcu & 7; }
    __device__ __forceinline__ bool next(int i, Unit& u) const { if (i >= 8) return false; u.pm = pm; u.pn = pn0 + i; return true; }
    __device__ __forceinline__ void a_ready(const Unit&) const {}
    __device__ __forceinline__ void done(const Unit&) const {}
};

__device__ __forceinline__ unsigned cvt_pk_bf16(float lo, float hi) { unsigned r; asm volatile("v_cvt_pk_bf16_f32 %0, %1, %2" : "=v"(r) : "v"(lo), "v"(hi)); return r; }

struct EpiBf16 {
    static constexpr bool PERM = true, AFTER_DRAIN = false;
    bf16_t* O; int ldc; const float* rscale;
    __device__ __forceinline__ void operator()(const f32x4 (&acc)[2][2][4][2], const Unit& u, int wr, int wc, int fr, int fq) const {
        int row0 = u.pm * BM + wr * 64 + fr; asm volatile("" : "+v"(row0));
        const int col0 = u.pn * BM + wc * 32 + 8 * fq;
#pragma unroll
        for (int ai = 0; ai < 2; ++ai)
#pragma unroll
            for (int m = 0; m < 4; ++m) { const int row = row0 + ai * HALF + m * 16; bf16_t* rowp = O + (size_t)row * ldc + col0;
                const float sc = rscale ? rscale[row] : 1.f;
#pragma unroll
                for (int bj = 0; bj < 2; ++bj) { const f32x4 v0 = acc[ai][bj][m][0] * sc, v1 = acc[ai][bj][m][1] * sc;
                    u32x4 w; w.x = cvt_pk_bf16(v0[0], v0[1]); w.y = cvt_pk_bf16(v0[2], v0[3]); w.z = cvt_pk_bf16(v1[0], v1[1]); w.w = cvt_pk_bf16(v1[2], v1[3]);
                    *(u32x4*)(rowp + bj * HALF) = w; } }
    }
};
struct EpiF8 {
    static constexpr bool PERM = true, AFTER_DRAIN = false;
    unsigned char* O; int ldc; const float* rscale;
    __device__ __forceinline__ void operator()(const f32x4 (&acc)[2][2][4][2], const Unit& u, int wr, int wc, int fr, int fq) const {
        int row0 = u.pm * BM + wr * 64 + fr; asm volatile("" : "+v"(row0));
        const int col0 = u.pn * BM + wc * 32 + 8 * fq;
#pragma unroll
        for (int ai = 0; ai < 2; ++ai)
#pragma unroll
            for (int m = 0; m < 4; ++m) { const int row = row0 + ai * HALF + m * 16; unsigned char* rowp = O + (size_t)row * ldc + col0;
                const float sc = rscale[row];
#pragma unroll
                for (int bj = 0; bj < 2; ++bj) { const f32x4 v0 = acc[ai][bj][m][0] * sc, v1 = acc[ai][bj][m][1] * sc;
                    u32x2 w; w.x = pk4_e4m3(v0[0], v0[1], v0[2], v0[3]); w.y = pk4_e4m3(v1[0], v1[1], v1[2], v1[3]);
                    *(u32x2*)(rowp + bj * HALF) = w; } }
    }
};
struct EpiInB {
    static constexpr bool PERM = true, AFTER_DRAIN = false;
    bf16_t* O; int ldc; const float* rscale; int uoff, boff;
    __device__ __forceinline__ void operator()(const f32x4 (&acc)[2][2][4][2], const Unit& u, int wr, int wc, int fr, int fq) const {
        int row0 = u.pm * BM + wr * 64 + fr; asm volatile("" : "+v"(row0));
        if (u.pn < 3) {
            const int col0 = uoff + u.pn * HALF + wc * 32 + 8 * fq;
#pragma unroll
            for (int ai = 0; ai < 2; ++ai)
#pragma unroll
                for (int m = 0; m < 4; ++m) { const int row = row0 + ai * HALF + m * 16; const float sc = rscale[row], s2 = sc * sc;
                    const f32x4 p0 = acc[ai][0][m][0] * acc[ai][1][m][0] * s2, p1 = acc[ai][0][m][1] * acc[ai][1][m][1] * s2;
                    u32x4 w; w.x = cvt_pk_bf16(p0[0], p0[1]); w.y = cvt_pk_bf16(p0[2], p0[3]); w.z = cvt_pk_bf16(p1[0], p1[1]); w.w = cvt_pk_bf16(p1[2], p1[3]);
                    *(u32x4*)(O + (size_t)row * ldc + col0) = w; }
        } else {
            const int col0 = boff + (u.pn - 3) * BM + wc * 32 + 8 * fq;
#pragma unroll
            for (int ai = 0; ai < 2; ++ai)
#pragma unroll
                for (int m = 0; m < 4; ++m) { const int row = row0 + ai * HALF + m * 16; bf16_t* rowp = O + (size_t)row * ldc + col0; const float sc = rscale[row];
#pragma unroll
                    for (int bj = 0; bj < 2; ++bj) { const f32x4 v0 = acc[ai][bj][m][0] * sc, v1 = acc[ai][bj][m][1] * sc;
                        u32x4 w; w.x = cvt_pk_bf16(v0[0], v0[1]); w.y = cvt_pk_bf16(v0[2], v0[3]); w.z = cvt_pk_bf16(v1[0], v1[1]); w.w = cvt_pk_bf16(v1[2], v1[3]);
                        *(u32x4*)(rowp + bj * HALF) = w; } }
        }
    }
};
struct EpiResBf16 {
    static constexpr bool PERM = true, AFTER_DRAIN = false;
    const bf16_t* base; bf16_t* out; int ldc; float* ss; unsigned char* o8; float s8;
    __device__ __forceinline__ void operator()(const f32x4 (&acc)[2][2][4][2], const Unit& u, int wr, int wc, int fr, int fq) const {
        int row0 = u.pm * BM + wr * 64 + fr; asm volatile("" : "+v"(row0));
        const int col0 = u.pn * BM + wc * 32 + 8 * fq;
#pragma unroll
        for (int ai = 0; ai < 2; ++ai) {
            u32x4 b[4][2];
#pragma unroll
            for (int m = 0; m < 4; ++m)
#pragma unroll
                for (int bj = 0; bj < 2; ++bj) b[m][bj] = *(const u32x4*)(base + (size_t)(row0 + ai * HALF + m * 16) * ldc + col0 + bj * HALF);
#pragma unroll
            for (int m = 0; m < 4; ++m) { const int row = row0 + ai * HALF + m * 16; float q = 0.f;
#pragma unroll
                for (int bj = 0; bj < 2; ++bj) { const u32x4 bb = b[m][bj]; f32x4 v0 = acc[ai][bj][m][0], v1 = acc[ai][bj][m][1];
                    v0[0] += __builtin_bit_cast(float, bb.x << 16); v0[1] += __builtin_bit_cast(float, bb.x & 0xffff0000u); v0[2] += __builtin_bit_cast(float, bb.y << 16); v0[3] += __builtin_bit_cast(float, bb.y & 0xffff0000u);
                    v1[0] += __builtin_bit_cast(float, bb.z << 16); v1[1] += __builtin_bit_cast(float, bb.z & 0xffff0000u); v1[2] += __builtin_bit_cast(float, bb.w << 16); v1[3] += __builtin_bit_cast(float, bb.w & 0xffff0000u);
                    q += (v0[0] * v0[0] + v0[1] * v0[1]) + (v0[2] * v0[2] + v0[3] * v0[3]) + (v1[0] * v1[0] + v1[1] * v1[1]) + (v1[2] * v1[2] + v1[3] * v1[3]);
                    u32x4 w; w.x = cvt_pk_bf16(v0[0], v0[1]); w.y = cvt_pk_bf16(v0[2], v0[3]); w.z = cvt_pk_bf16(v1[0], v1[1]); w.w = cvt_pk_bf16(v1[2], v1[3]);
                    *(u32x4*)(out + (size_t)row * ldc + col0 + bj * HALF) = w;
                    if (o8) { u32x2 w8; w8.x = pk4_e4m3(v0[0] * s8, v0[1] * s8, v0[2] * s8, v0[3] * s8); w8.y = pk4_e4m3(v1[0] * s8, v1[1] * s8, v1[2] * s8, v1[3] * s8);
                        *(u32x2*)(o8 + (size_t)row * ldc + col0 + bj * HALF) = w8; } }
                q += __shfl_xor(q, 16); q += __shfl_xor(q, 32);
                if (fq == 0) ss[(size_t)row * 16 + 4 * u.pn + wc] = q; }
        }
    }
};
__device__ __forceinline__ float silu_mul(float g, float u) { return g * __builtin_amdgcn_rcpf(1.0f + __builtin_amdgcn_exp2f(-1.4426950408889634f * g)) * u; }
struct EpiSwiGLU {
    static constexpr bool PERM = true, AFTER_DRAIN = false;
    bf16_t* O; int ldc; const float* rscale;
    __device__ __forceinline__ void operator()(const f32x4 (&acc)[2][2][4][2], const Unit& u, int wr, int wc, int fr, int fq) const {
        int row0 = u.pm * BM + wr * 64 + fr; asm volatile("" : "+v"(row0));
        const int col0 = u.pn * HALF + wc * 32 + 8 * fq;
#pragma unroll
        for (int ai = 0; ai < 2; ++ai)
#pragma unroll
            for (int m = 0; m < 4; ++m) { const int row = row0 + ai * HALF + m * 16; bf16_t* rowp = O + (size_t)row * ldc + col0; const float sc = rscale[row];
                const f32x4 g0 = acc[ai][0][m][0] * sc, g1 = acc[ai][0][m][1] * sc, u0 = acc[ai][1][m][0] * sc, u1 = acc[ai][1][m][1] * sc;
                u32x4 w; w.x = cvt_pk_bf16(silu_mul(g0[0], u0[0]), silu_mul(g0[1], u0[1])); w.y = cvt_pk_bf16(silu_mul(g0[2], u0[2]), silu_mul(g0[3], u0[3]));
                w.z = cvt_pk_bf16(silu_mul(g1[0], u1[0]), silu_mul(g1[1], u1[1])); w.w = cvt_pk_bf16(silu_mul(g1[2], u1[2]), silu_mul(g1[3], u1[3]));
                *(u32x4*)rowp = w; }
    }
};

struct EpiSwiGLU8 {
    static constexpr bool PERM = true, AFTER_DRAIN = false;
    unsigned char* O; int ldc; const float* rscale; float oscale;
    __device__ __forceinline__ void operator()(const f32x4 (&acc)[2][2][4][2], const Unit& u, int wr, int wc, int fr, int fq) const {
        int row0 = u.pm * BM + wr * 64 + fr; asm volatile("" : "+v"(row0));
        const int col0 = u.pn * HALF + wc * 32 + 8 * fq;
#pragma unroll
        for (int ai = 0; ai < 2; ++ai)
#pragma unroll
            for (int m = 0; m < 4; ++m) { const int row = row0 + ai * HALF + m * 16; unsigned char* rowp = O + (size_t)row * ldc + col0; const float sc = rscale[row], su = sc * oscale;
                const f32x4 g0 = acc[ai][0][m][0] * sc, g1 = acc[ai][0][m][1] * sc, u0 = acc[ai][1][m][0] * su, u1 = acc[ai][1][m][1] * su;
                u32x2 w; w.x = pk4_e4m3(silu_mul(g0[0], u0[0]), silu_mul(g0[1], u0[1]), silu_mul(g0[2], u0[2]), silu_mul(g0[3], u0[3]));
                w.y = pk4_e4m3(silu_mul(g1[0], u1[0]), silu_mul(g1[1], u1[1]), silu_mul(g1[2], u1[2]), silu_mul(g1[3], u1[3]));
                *(u32x2*)rowp = w; }
    }
};

template <class Epi, class Sched, bool ALIGN_EPI = false, bool SP2 = false, bool GATHER = false, bool FP8 = false>
__device__ __forceinline__ void gemm_phase(PG8_LAS unsigned char* lds, const Gemm g, const Sched& S, const Epi& E) {
    int tid_ = threadIdx.x; asm volatile("" : "+v"(tid_));
    const int tid = tid_, wid = __builtin_amdgcn_readfirstlane(tid >> 6), lane = tid & 63, wr = wid >> 2, wc = wid & 3, fr = lane & 15, fq = lane >> 4;
    const int K = g.K, nt = K / BK;
    unsigned voffA[2], voffA1[2], voffB[2];
    const size_t hstep = (size_t)HALF * K * 2;
    Unit cur, nxt; int ui = 0;
    if (!S.next(0, cur)) return;
#pragma unroll
    for (int i = 0; i < 2; ++i) { int R, C; stage_rc(tid * 16 + i * 8192, R, C); const int Rb = Epi::PERM ? ((R & ~31) + perm32(R & 31)) : R;
        if constexpr (GATHER) { const int r0 = g.aidx[cur.pm * BM + R], r1 = g.aidx[cur.pm * BM + HALF + R]; voffA[i] = (unsigned)(r0 * K + C) * 2u; voffA1[i] = (unsigned)(r1 * K + C) * 2u; }
        else { voffA[i] = (unsigned)(R * K + C) * 2u; voffA1[i] = voffA[i] + (unsigned)hstep; }
        voffB[i] = (unsigned)(Rb * K + C) * 2u; }
    const size_t kstep = (size_t)(BK * 2);
    const size_t tstep = 2 * hstep;
    const size_t gbytes = g.gstride * 2;
    const unsigned ldsw = (unsigned)wid * 1024u;
    const int aoff = lds_byte(wr * 64 + fr, fq * 8), boff = lds_byte(wc * 32 + fr, fq * 8);
#define PG8_SA(b, h) (((b) * 2 + (h)) * HTB)
#define PG8_SB(b, h) ((4 + (b) * 2 + (h)) * HTB)
#define PG8_STAGE(bufoff, gbase, voff) do { _Pragma("unroll") for (int _i = 0; _i < 2; ++_i) \
        __builtin_amdgcn_global_load_lds((const unsigned*)((const char*)(gbase) + (voff)[_i]), (PG8_LAS unsigned*)(lds + (bufoff) + ldsw + _i * 8192), 16, 0, 0); } while (0)
#define PG8_LDA(dst, b, h) do { _Pragma("unroll") for (int m = 0; m < 4; ++m) _Pragma("unroll") for (int k = 0; k < 2; ++k) dst[m][k] = *(const PG8_LAS bf16x8*)(lds + PG8_SA(b, h) + aoff + m * 2048 + k * 1024); } while (0)
#define PG8_LDB(dst, b, h) do { _Pragma("unroll") for (int n = 0; n < 2; ++n) _Pragma("unroll") for (int k = 0; k < 2; ++k) dst[n][k] = *(const PG8_LAS bf16x8*)(lds + PG8_SB(b, h) + boff + n * 2048 + k * 1024); } while (0)
#define PG8_MMA(ai, bj, At, Bt) do { __builtin_amdgcn_s_setprio(1); \
        if constexpr (FP8) { _Pragma("unroll") for (int m = 0; m < 4; ++m) _Pragma("unroll") for (int n = 0; n < 2; ++n) \
            mfma8(acc[ai][bj][m][n], cat8(Bt[n][0], Bt[n][1]), cat8(At[m][0], At[m][1])); } \
        else { _Pragma("unroll") for (int m = 0; m < 4; ++m) _Pragma("unroll") for (int n = 0; n < 2; ++n) _Pragma("unroll") for (int k = 0; k < 2; ++k) \
            acc[ai][bj][m][n] = __builtin_amdgcn_mfma_f32_16x16x32_bf16(Bt[n][k], At[m][k], acc[ai][bj][m][n], 0, 0, 0); } \
        __builtin_amdgcn_s_setprio(0); } while (0)
#define PG8_WAIT_V(n) asm volatile("s_waitcnt vmcnt(" #n ")" ::: "memory")
#define PG8_WAIT_L(n) asm volatile("s_waitcnt lgkmcnt(" #n ")" ::: "memory")
#define PG8_BAR __builtin_amdgcn_s_barrier()
#define PG8_SCHED __builtin_amdgcn_sched_barrier(0)
    f32x4 acc[2][2][4][2];
#pragma unroll
    for (int a = 0; a < 2; ++a)
#pragma unroll
        for (int b = 0; b < 2; ++b)
#pragma unroll
            for (int m = 0; m < 4; ++m)
#pragma unroll
                for (int n = 0; n < 2; ++n) acc[a][b][m][n] = (f32x4){0.f, 0.f, 0.f, 0.f};
    bf16x8 At[4][2], B0[2][2], B1[2][2];
    const char* cA = (const char*)g.A + (GATHER ? (size_t)0 : (size_t)cur.pm * tstep); const char* cB = (const char*)g.Bt + (size_t)(cur.pm / g.gm) * gbytes + (size_t)cur.pn * tstep;
    S.a_ready(cur);
    if constexpr (SP2) {
        PG8_STAGE(PG8_SB(0, 0), cB, voffB); PG8_STAGE(PG8_SB(0, 1), cB + hstep, voffB); PG8_STAGE(PG8_SA(0, 0), cA, voffA); PG8_STAGE(PG8_SA(0, 1), cA, voffA1);
        if (wr == 1) PG8_BAR;
        PG8_WAIT_V(2); PG8_BAR;
        PG8_STAGE(PG8_SB(1, 0), cB + kstep, voffB); PG8_STAGE(PG8_SA(1, 0), cA + kstep, voffA); PG8_STAGE(PG8_SB(1, 1), cB + hstep + kstep, voffB);
        PG8_WAIT_V(6); PG8_BAR;
    } else {
        PG8_STAGE(PG8_SB(0, 0), cB, voffB); PG8_STAGE(PG8_SA(0, 0), cA, voffA); PG8_STAGE(PG8_SB(0, 1), cB + hstep, voffB); PG8_STAGE(PG8_SA(0, 1), cA, voffA1);
        if (wr == 1) PG8_BAR;
        PG8_WAIT_V(4); PG8_BAR;
        PG8_STAGE(PG8_SB(1, 0), cB + kstep, voffB); PG8_STAGE(PG8_SA(1, 0), cA + kstep, voffA); PG8_STAGE(PG8_SB(1, 1), cB + hstep + kstep, voffB);
        PG8_WAIT_V(6); PG8_BAR;
    }
    for (;;) {
        const bool has_next = S.next(ui + 1, nxt);
        const char* nA = (has_next && !GATHER) ? (const char*)g.A + (size_t)nxt.pm * tstep : cA; const char* nB = has_next ? (const char*)g.Bt + (size_t)(nxt.pm / g.gm) * gbytes + (size_t)nxt.pn * tstep : cB;
        for (int t = 0; t < nt; t += 2) {
            const bool last = (t == nt - 2);
            const char* a1 = cA + (size_t)(t + 1) * kstep;
            const char* a2 = last ? nA : cA + (size_t)(t + 2) * kstep; const char* b2 = last ? nB : cB + (size_t)(t + 2) * kstep;
            const char* a3 = a2 + kstep; const char* b3 = b2 + kstep;
            if (last && has_next) S.a_ready(nxt);
            if constexpr (SP2) {
            PG8_LDB(B0, 0, 0); PG8_LDB(B1, 0, 1); PG8_SCHED; PG8_LDA(At, 0, 0); PG8_STAGE(PG8_SA(1, 1), a1, voffA1);
            PG8_WAIT_V(8); PG8_WAIT_L(0); PG8_BAR; PG8_MMA(0, 0, At, B0); PG8_MMA(0, 1, At, B1); PG8_BAR; PG8_SCHED;
            PG8_LDA(At, 0, 1); PG8_STAGE(PG8_SB(0, 0), b2, voffB); PG8_STAGE(PG8_SB(0, 1), b2 + hstep, voffB); PG8_STAGE(PG8_SA(0, 0), a2, voffA);
            PG8_WAIT_V(8); PG8_WAIT_L(0); PG8_BAR; PG8_MMA(1, 0, At, B0); PG8_MMA(1, 1, At, B1); PG8_BAR; PG8_SCHED;
            PG8_LDB(B0, 1, 0); PG8_LDB(B1, 1, 1); PG8_SCHED; PG8_LDA(At, 1, 0); PG8_STAGE(PG8_SA(0, 1), a2, voffA1);
            PG8_WAIT_V(8); PG8_WAIT_L(0); PG8_BAR; PG8_MMA(0, 0, At, B0); PG8_MMA(0, 1, At, B1); PG8_BAR; PG8_SCHED;
            PG8_LDA(At, 1, 1); PG8_STAGE(PG8_SB(1, 0), b3, voffB); PG8_STAGE(PG8_SB(1, 1), b3 + hstep, voffB); PG8_STAGE(PG8_SA(1, 0), a3, voffA);
            PG8_WAIT_V(8); PG8_WAIT_L(0); PG8_BAR; PG8_MMA(1, 0, At, B0); PG8_MMA(1, 1, At, B1); PG8_BAR; PG8_SCHED;
            } else {
            PG8_LDB(B0, 0, 0); PG8_SCHED; PG8_LDA(At, 0, 0); PG8_STAGE(PG8_SA(1, 1), a1, voffA1);
            PG8_WAIT_L(8); PG8_BAR; PG8_WAIT_L(0); PG8_MMA(0, 0, At, B0); PG8_BAR; PG8_SCHED;
            PG8_LDB(B1, 0, 1); PG8_STAGE(PG8_SB(0, 0), b2, voffB);
            PG8_BAR; PG8_WAIT_L(0); PG8_MMA(0, 1, At, B1); PG8_BAR;
            PG8_LDA(At, 0, 1); PG8_STAGE(PG8_SA(0, 0), a2, voffA);
            PG8_BAR; PG8_WAIT_L(0); PG8_MMA(1, 0, At, B0); PG8_BAR; PG8_SCHED;
            PG8_STAGE(PG8_SB(0, 1), b2 + hstep, voffB);
            PG8_WAIT_V(6); PG8_BAR; PG8_MMA(1, 1, At, B1); PG8_BAR;
            PG8_LDB(B0, 1, 0); PG8_SCHED; PG8_LDA(At, 1, 0); PG8_STAGE(PG8_SA(0, 1), a2, voffA1);
            PG8_WAIT_L(8); PG8_BAR; PG8_WAIT_L(0); PG8_MMA(0, 0, At, B0); PG8_BAR; PG8_SCHED;
            PG8_LDB(B1, 1, 1); PG8_STAGE(PG8_SB(1, 0), b3, voffB);
            PG8_BAR; PG8_WAIT_L(0); PG8_MMA(0, 1, At, B1); PG8_BAR;
            PG8_LDA(At, 1, 1); PG8_STAGE(PG8_SA(1, 0), a3, voffA);
            PG8_BAR; PG8_WAIT_L(0); PG8_MMA(1, 0, At, B0); PG8_BAR; PG8_SCHED;
            PG8_STAGE(PG8_SB(1, 1), b3 + hstep, voffB);
            PG8_WAIT_V(6); PG8_BAR; PG8_MMA(1, 1, At, B1); PG8_BAR;
            }
        }
        if constexpr (FP8) asm volatile("s_nop 15\n\ts_nop 15" ::: "memory");
        if constexpr (ALIGN_EPI) { if (wr == 0) PG8_BAR; }
        if constexpr (!Epi::AFTER_DRAIN) { E(acc, cur, wr, wc, fr, fq); S.done(cur); }
        if constexpr (Sched::PREFETCH) {
            Unit u2; if (S.next(ui + 2, u2) && wid < 4) {
                const char* pb = (const char*)g.Bt + (size_t)(u2.pm / g.gm) * gbytes + (size_t)u2.pn * tstep + (size_t)S.slice * (tstep >> 3) + (size_t)(wid * 64 + lane) * 128;
                __builtin_amdgcn_global_load_lds((const __attribute__((address_space(1))) unsigned*)pb, (PG8_LAS unsigned*)(lds + STAGE_BYTES + wid * 256), 4, 0, 0); } }
        if (!has_next) break;
#pragma unroll
        for (int a = 0; a < 2; ++a)
#pragma unroll
            for (int b = 0; b < 2; ++b)
#pragma unroll
                for (int m = 0; m < 4; ++m)
#pragma unroll
                    for (int n = 0; n < 2; ++n) acc[a][b][m][n] = (f32x4){0.f, 0.f, 0.f, 0.f};
        cur = nxt; cA = nA; cB = nB; ++ui;
        if constexpr (ALIGN_EPI) { if (wr == 1) PG8_BAR; }
    }
    PG8_WAIT_V(0);
    if constexpr (!ALIGN_EPI) { if (wr == 0) PG8_BAR; }
    PG8_BAR;
#undef PG8_SA
#undef PG8_SB
#undef PG8_STAGE
#undef PG8_LDA
#undef PG8_LDB
#undef PG8_MMA
#undef PG8_WAIT_V
#undef PG8_WAIT_L
#undef PG8_BAR
#undef PG8_SCHED
}
}

typedef GAS unsigned gu32;
#define XB_TMO      128
#define XB_XCNT(j)  (256  + 64 * (j))
#define XB_XSUB(j)  (1280 + 64 * (j))
#define XB_XGEN(j)  (2304 + 64 * (j))
#define XB_TOP      3328
#define XB_TOPGEN   3392
#define XB_SPIN_CAP (1u << 20)

__device__ __forceinline__ unsigned xb_ld(unsigned* p)              { return __hip_atomic_load(p, __ATOMIC_RELAXED, __HIP_MEMORY_SCOPE_AGENT); }
__device__ __forceinline__ unsigned xb_add(unsigned* p, unsigned v) { return __hip_atomic_fetch_add(p, v, __ATOMIC_RELAXED, __HIP_MEMORY_SCOPE_AGENT); }
__device__ __forceinline__ unsigned xb_xcc_id() { return (unsigned)__builtin_amdgcn_s_getreg((3 << 11) | 20) & 0xFu; }
#define XB_SPIN(cond, bar) do { unsigned _sp = 0; while (cond) { __builtin_amdgcn_s_sleep(1); \
    if ((++_sp & 255u) == 0u) { if (xb_ld(&(bar)[XB_TMO])) break; if (_sp > XB_SPIN_CAP) { atomicAdd(&(bar)[XB_TMO], 1u); break; } } } } while (0)

#define XB_EXIT     3456
#if ONE_LAUNCH
__device__ unsigned g_barrier_words[XB_EXIT + 64];
#endif
struct XcdBarrier { unsigned* bar; unsigned x; volatile LAS unsigned* st; };
__device__ __forceinline__ XcdBarrier xcd_barrier_post(unsigned* bar, volatile LAS unsigned* st) {
    XcdBarrier b; b.bar = bar; b.x = xb_xcc_id(); b.st = st;
    if (threadIdx.x == 0) (void)xb_add(&bar[XB_XCNT(b.x)], 1u);
    return b;
}
__device__ __forceinline__ void xcd_barrier_complete(unsigned* bar, unsigned x, unsigned& nloc, unsigned& nx) {
    const unsigned G = gridDim.x * gridDim.y * gridDim.z;
    unsigned sum, cnt, mine, sp = 0u;
    for (;;) {
        sum = 0u; cnt = 0u; mine = 0u;
#pragma unroll
        for (unsigned j = 0; j < 16; ++j) { const unsigned c = xb_ld(&bar[XB_XCNT(j)]); sum += c; cnt += (c > 0u) ? 1u : 0u; mine = (j == x) ? c : mine; }
        if (sum == G) break;
        __builtin_amdgcn_s_sleep(1);
        if ((++sp & 255u) == 0u) { if (xb_ld(&bar[XB_TMO])) break; if (sp > XB_SPIN_CAP) { atomicAdd(&bar[XB_TMO], 1u); break; } }
    }
    nloc = mine > 0u ? mine : 1u; nx = cnt > 0u ? cnt : 1u;
}
__device__ __forceinline__ void xcd_barrier(const XcdBarrier& b, bool opp = false) {
    asm volatile("s_waitcnt vmcnt(0)" ::: "memory");
    __syncthreads();
    if (threadIdx.x == 0) {
        unsigned* bar = b.bar;
        __builtin_amdgcn_s_waitcnt(0);
        unsigned nloc = b.st[0], nx = b.st[1];
        if (nloc == 0u) { xcd_barrier_complete(bar, b.x, nloc, nx); b.st[0] = nloc; b.st[1] = nx; }
        const unsigned old = xb_add(&bar[XB_XSUB(b.x)], 1u);
        const unsigned gen = old / nloc;
        b.st[2] = 0u;
        if (opp && (old + 1u != (gen + 1u) * nloc) && (old - gen * nloc) * 8u < nloc * (unsigned)OPP_ELIG8) { b.st[2] = 1u; b.st[3] = gen; }
        else if (old + 1u == (gen + 1u) * nloc) {
            __builtin_amdgcn_fence(__ATOMIC_RELEASE, "agent");
            asm volatile("s_waitcnt vmcnt(0)" ::: "memory");
            const unsigned og = xb_add(&bar[XB_TOP], 1u);
            const unsigned tg = og / nx;
            if (og + 1u == (tg + 1u) * nx) xb_add(&bar[XB_TOPGEN], 1u);
            else XB_SPIN(xb_ld(&bar[XB_TOPGEN]) == tg, bar);
            __builtin_amdgcn_fence(__ATOMIC_ACQUIRE, "agent");
            xb_add(&bar[XB_XGEN(b.x)], 1u);
            asm volatile("s_waitcnt vmcnt(0)" ::: "memory");
        } else {
            XB_SPIN(xb_ld(&bar[XB_XGEN(b.x)]) == gen, bar);
            __builtin_amdgcn_fence(__ATOMIC_ACQUIRE, "agent");
            asm volatile("s_waitcnt vmcnt(0)" ::: "memory");
        }
    }
    __syncthreads();
}
__device__ __forceinline__ void xcd_barrier_wait(const XcdBarrier& b) {
    __syncthreads();
    if (threadIdx.x == 0) {
        const unsigned gen = b.st[3];
        XB_SPIN(xb_ld(&b.bar[XB_XGEN(b.x)]) == gen, b.bar);
        __builtin_amdgcn_fence(__ATOMIC_ACQUIRE, "agent");
        asm volatile("s_waitcnt vmcnt(0)" ::: "memory");
    }
    __syncthreads();
}

struct Frame {
    LAS unsigned char* lds;
    int tid, lane, wave, vcu, G;
    const float *x, *mem, *mem_norm, *norm_mix, *w_in, *conv_w, *w_mem_kv, *w_out, *norm_ffn, *w_router, *w_gate, *w_up, *w_down, *norm_final;
    float* out;
    bf16 *WIN, *WKV, *WOUT, *WGU, *WDN, *XB, *X1B, *H, *OP, *MIX, *MEMN, *KVM, *XG, *HID;
    float *LSE, *AFFT, *GROW, *RS0, *SS1, *RS1, *RSLOT; short* INV; int* IDX; unsigned char* X1F8; unsigned char *XB8, *WIN8; float* RS0S;
};

__device__ __forceinline__ void tr_item(const float* W, int K, int N, bf16* WT, int mode, const float* gk, LAS float* scr, int item, int lane, float cs = 1.f, int ldw = 0, int drow = -1) {
    if (ldw == 0) ldw = N;
    const int nblk = N / 32, kb = item / nblk, nb = item % nblk, k0 = 64 * kb, n0 = 32 * nb;
    const int drow0 = (drow >= 0) ? drow : (mode == 0) ? n0 : ((n0 >> 7) * 256 + (n0 & 127) + (mode == 2 ? 128 : 0));
    { f32x4 w[8];
#pragma unroll
      for (int i = 0; i < 8; ++i) w[i] = __builtin_nontemporal_load((const GAS f32x4*)(W + (size_t)(k0 + 8 * i + (lane >> 3)) * ldw + n0 + 4 * (lane & 7)));
#pragma unroll
      for (int i = 0; i < 8; ++i) { const float gg = gk ? gk[k0 + 8 * i + (lane >> 3)] * cs : cs; LAS float* d = scr + (8 * i + (lane >> 3)) * 33 + 4 * (lane & 7); d[0] = w[i].x * gg; d[1] = w[i].y * gg; d[2] = w[i].z * gg; d[3] = w[i].w * gg; } }
    LDS_WAIT(); asm volatile("" ::: "memory");
    const int c = lane & 7;
#pragma unroll
    for (int j = 0; j < 4; ++j) { const int n = (lane >> 3) + 8 * j; const LAS float* s = scr + (8 * c) * 33 + n;
        v4u o; o.x = cvtpk_s(s[0 * 33], s[1 * 33]); o.y = cvtpk_s(s[2 * 33], s[3 * 33]); o.z = cvtpk_s(s[4 * 33], s[5 * 33]); o.w = cvtpk_s(s[6 * 33], s[7 * 33]);
        __builtin_nontemporal_store(o, (GAS v4u*)(WT + (size_t)(drow0 + n) * K + k0 + 8 * c)); }
    LDS_WAIT(); asm volatile("" ::: "memory");
}
__device__ __forceinline__ void tr_item8(const float* W, int K, int N, unsigned char* WT, int mode, const float* gk, float sc, LAS float* scr, int item, int lane, int ldw = 0) {
    if (ldw == 0) ldw = N;
    const int nblk = N / 32, kb = item / nblk, nb = item % nblk, k0 = 128 * kb, n0 = 32 * nb;
    const int drow0 = (mode == 0) ? n0 : ((n0 >> 7) * 256 + (n0 & 127) + (mode == 2 ? 128 : 0));
    const float* src = W + (size_t)(k0 + (lane >> 3)) * ldw + n0 + 4 * (lane & 7);
    LAS unsigned char* sb = (LAS unsigned char*)scr;
#pragma unroll
    for (int i = 0; i < 16; ++i) __builtin_amdgcn_global_load_lds((const GAS unsigned*)(src + (size_t)(8 * i) * ldw), (LAS unsigned*)(sb + i * 1040), 16, 0, CONV_DMA_AUX);
    const int c = lane & 7;
    f32x4 g[4];
#pragma unroll
    for (int q = 0; q < 4; ++q) { if (gk) g[q] = *(const GAS f32x4*)(gk + k0 + 16 * c + 4 * q) * sc; else g[q] = (f32x4){sc, sc, sc, sc}; }
    asm volatile("s_waitcnt vmcnt(0)" ::: "memory");
#pragma unroll
    for (int j = 0; j < 4; ++j) { const int n = (lane >> 3) + 8 * j; const LAS float* s0 = (const LAS float*)(sb + (2 * c) * 1040) + n; const LAS float* s1 = (const LAS float*)(sb + (2 * c + 1) * 1040) + n;
        v4u o; o.x = pg8::pk4_e4m3(s0[0 * 32] * g[0].x, s0[1 * 32] * g[0].y, s0[2 * 32] * g[0].z, s0[3 * 32] * g[0].w); o.y = pg8::pk4_e4m3(s0[4 * 32] * g[1].x, s0[5 * 32] * g[1].y, s0[6 * 32] * g[1].z, s0[7 * 32] * g[1].w);
        o.z = pg8::pk4_e4m3(s1[0 * 32] * g[2].x, s1[1 * 32] * g[2].y, s1[2 * 32] * g[2].z, s1[3 * 32] * g[2].w); o.w = pg8::pk4_e4m3(s1[4 * 32] * g[3].x, s1[5 * 32] * g[3].y, s1[6 * 32] * g[3].z, s1[7 * 32] * g[3].w);
        __builtin_nontemporal_store(o, (GAS v4u*)(WT + (size_t)(drow0 + n) * K + k0 + 16 * c)); }
    LDS_WAIT(); asm volatile("" ::: "memory");
}
__device__ __forceinline__ void rms_row_to_bf16(const float* xrow, const float* g, bf16* orow, int lane) {
    const GAS f32x4* xr = (const GAS f32x4*)xrow + lane; const GAS f32x4* gr = (const GAS f32x4*)g + lane;
    f32x4 v[4]; float s = 0.f;
#pragma unroll
    for (int j = 0; j < 4; ++j) { v[j] = xr[64 * j]; s += (v[j].x * v[j].x + v[j].y * v[j].y) + (v[j].z * v[j].z + v[j].w * v[j].w); }
    const float r = 1.0f / sqrtf(wave_sum(s) * (1.f / DM) + RMS_EPS);
    GAS unsigned long long* o8 = (GAS unsigned long long*)orow + lane;
#pragma unroll
    for (int j = 0; j < 4; ++j) { const f32x4 gg = gr[64 * j]; const f32x4 o = v[j] * r * gg;
        o8[64 * j] = (unsigned long long)pk2(o.x, o.y) | ((unsigned long long)pk2(o.z, o.w) << 32); }
}
constexpr bool GU8 = true, DN8 = true;
constexpr float SC_X1 = 16.f, SC_WGU = 128.f, SC_HID = 8.f, SC_WDN = 256.f, SC_Y = 64.f;
constexpr bool Y8 = true;
constexpr int CSCR_BYTES = 17408;
constexpr bool OP8 = true;
constexpr float SC_OP = 16.f;
constexpr bool IN8 = true;
constexpr int INB = 1280, INF = INW - INB;
constexpr float SC_XB = 16.f, SC_WIN = 128.f;
constexpr int CV_INB = 16 * (IN8 ? INB / 32 : 80), CV_INF = IN8 ? 8 * (INF / 32) : 0, CV_IN = CV_INB + CV_INF, CV_KV = 16 * 16, CV_OUT = 16 * 32, CV_SMALL = CV_IN + CV_KV + CV_OUT, CV_GU = GU8 ? 512 : 1024, CV_DN = DN8 ? 512 : 1024, CV_LE = 2 * CV_GU + CV_DN, NITEMS = 2 * CV_SMALL + 2 * NE * CV_LE;
constexpr int DEFER_PER = IN8 ? 2 : (GU8 ? 4 : 8);
constexpr int DEFER_WG0 = IN8 ? 256 : 160, N_DEFER0 = (256 - DEFER_WG0) * NWAVES * DEFER_PER;
constexpr int DEFER_WG1 = IN8 ? 192 : 128, N_DEFER1 = (256 - DEFER_WG1) * NWAVES * DEFER_PER;
constexpr int ATT_TAIL = GU8 ? 2 : 3, N_ATTT = 128 * NWAVES * ATT_TAIL;
constexpr int OPP_A = 7, N_OPPA = OPP_A * 256 * NWAVES;
constexpr int OPP_B = 9, N_OPPB = OPP_B * 256 * NWAVES, OPP_ROUNDS = OPP_A + OPP_B;
constexpr int OPP_LAST_PHASE = 1 + 9 + 3;
constexpr int SEG = NE * CV_LE, SEG0 = 2 * CV_SMALL, SEG1 = SEG0 + SEG;
constexpr int N_TAIL0 = N_OPPA + N_ATTT + N_DEFER0, N_TAIL1 = N_OPPB + N_ATTT + N_DEFER1;
static_assert(N_TAIL0 <= SEG && N_TAIL1 <= SEG, "tails");
__device__ __forceinline__ int defer_first(int l) { return (l == 0 ? SEG0 + SEG - N_DEFER0 : SEG1 + SEG - N_DEFER1); }
__device__ __forceinline__ int atail_first(int l) { return defer_first(l) - N_ATTT; }
__device__ __forceinline__ int pool_first(int r) { return r < OPP_A ? atail_first(0) - N_OPPA + r * (256 * NWAVES) : atail_first(1) - N_OPPB + (r - OPP_A) * (256 * NWAVES); }
__device__ __forceinline__ void conv_item(Frame& F, int it, LAS float* scr) {
    if (it < 2 * CV_SMALL) {
        const int l = it / CV_SMALL; int r = it % CV_SMALL;
        if (r < CV_INB) { const int n0 = 32 * (r % ((IN8 ? INB : INW) / 32));
            tr_item(F.w_in + (size_t)l * DM * INW, DM, IN8 ? INB : INW, F.WIN + (size_t)l * INW * DM, 0, F.norm_mix + (size_t)l * DM, scr, r, F.lane, ((n0 >= C_Q && n0 < C_K) || n0 >= C_QM) ? 0.125f * LOG2E : 1.f, INW,
                    n0 < C_BG ? (n0 >> 7) * 256 + (n0 & 127) : n0 < C_CG ? n0 + 384 : n0 < C_Q ? ((n0 - C_CG) >> 7) * 256 + ((n0 - C_CG) & 127) + 128 : n0); return; } r -= CV_INB;
        if (r < CV_INF) { const int n0 = INB + 32 * (r % (INF / 32));
            tr_item8(F.w_in + (size_t)l * DM * INW + INB, DM, INF, F.WIN8 + (size_t)l * INF * DM, 0, F.norm_mix + (size_t)l * DM, SC_WIN * (((n0 >= C_Q && n0 < C_K) || n0 >= C_QM) ? 0.125f * LOG2E : 1.f), scr, r, F.lane, INW); return; } r -= CV_INF;
        if (r < CV_KV) { tr_item(F.w_mem_kv + (size_t)l * DM * 512, DM, 512, F.WKV + (size_t)l * 512 * DM, 0, nullptr, scr, r, F.lane); return; } r -= CV_KV;
        tr_item(F.w_out + (size_t)l * DM * DM, DM, DM, F.WOUT + (size_t)l * DM * DM, 0, nullptr, scr, r, F.lane);
    } else {
        const int r = it - 2 * CV_SMALL; const int le = r / CV_LE, q = r % CV_LE;
        if (q < 2 * CV_GU) { const int up = q >= CV_GU, item = q - up * CV_GU; const float* W = (up ? F.w_up : F.w_gate) + (size_t)le * DM * FF; const float* gk = F.norm_ffn + (size_t)(le / NE) * DM;
            if (GU8) tr_item8(W, DM, FF, (unsigned char*)F.WGU + (size_t)le * 2 * FF * DM, 1 + up, gk, SC_WGU, scr, item, F.lane);
            else tr_item(W, DM, FF, F.WGU + (size_t)le * 2 * FF * DM, 1 + up, gk, scr, item, F.lane); }
        else { const int item = q - 2 * CV_GU;
            if (DN8) tr_item8(F.w_down + (size_t)le * FF * DM, FF, DM, (unsigned char*)F.WDN + (size_t)le * DM * FF, 0, nullptr, SC_WDN, scr, item, F.lane);
            else tr_item(F.w_down + (size_t)le * FF * DM, FF, DM, F.WDN + (size_t)le * DM * FF, 0, nullptr, scr, item, F.lane); }
    }
}
__device__ __forceinline__ void p0_prologue(Frame& F, int part) {
    LAS float* scr = (LAS float*)(F.lds + F.wave * CSCR_BYTES);
    const int gw = F.vcu * NWAVES + F.wave, NGW = F.G * NWAVES;
    if (part == 1) { constexpr int n1 = SEG - N_TAIL0, n2 = SEG - N_TAIL1;
        for (int j = gw; j < n1 + n2; j += NGW) conv_item(F, j < n1 ? SEG0 + j : SEG1 + (j - n1), scr); return; }
    for (int it = gw; it < 2 * CV_SMALL; it += NGW) conv_item(F, it, scr);
    for (int m = gw; m < NB * MEMT; m += NGW) rms_row_to_bf16(F.mem + (size_t)m * DM, F.mem_norm, F.MEMN + (size_t)m * DM, F.lane);
    for (int m = gw; m < T; m += NGW) {
        const GAS f32x4* xr = (const GAS f32x4*)(F.x + (size_t)m * DM) + F.lane; f32x4 v[4]; float ss = 0.f;
#pragma unroll
        for (int j = 0; j < 4; ++j) { v[j] = __builtin_nontemporal_load(xr + 64 * j); ss += (v[j].x * v[j].x + v[j].y * v[j].y) + (v[j].z * v[j].z + v[j].w * v[j].w); }
        GAS unsigned long long* o8 = (GAS unsigned long long*)(F.XB + (size_t)m * DM) + F.lane;
#pragma unroll
        for (int j = 0; j < 4; ++j) o8[64 * j] = (unsigned long long)pk2(v[j].x, v[j].y) | ((unsigned long long)pk2(v[j].z, v[j].w) << 32);
        const float r = 1.0f / sqrtf(wave_sum(ss) * (1.f / DM) + RMS_EPS);
        if (F.lane == 0) { F.RS0[m] = r; if (IN8) F.RS0S[m] = r * (1.f / (SC_XB * SC_WIN)); }
        if (IN8) { GAS unsigned* o4 = (GAS unsigned*)(F.XB8 + (size_t)m * DM) + F.lane;
#pragma unroll
            for (int j = 0; j < 4; ++j) o4[64 * j] = pg8::pk4_e4m3(v[j].x * SC_XB, v[j].y * SC_XB, v[j].z * SC_XB, v[j].w * SC_XB); }
    }
}

__device__ __forceinline__ s16x4 vtr(LAS unsigned char* p) { typedef short v4i16_t __attribute__((ext_vector_type(4))); return __builtin_bit_cast(s16x4, __builtin_amdgcn_ds_read_tr16_b64_v4i16((LAS v4i16_t*)p)); }
constexpr int KROW = 144;
constexpr int VROW = 192;
template <bool DIL, bool O8 = false>
__device__ __forceinline__ void attn_item(const bf16* qp, long q_rs, const bf16* kp, const bf16* vp, long kv_rs, int t_lo, int t_hi, int nt_total, float c2,
                                          bf16* op, long o_rs, float* lsep, long lse_rs, LAS unsigned char* kbuf, LAS unsigned char* vbuf, int lane) {
    const int ql = lane & 31, hh = lane >> 5;
    bf16x8 qf[4];
#pragma unroll
    for (int s = 0; s < 4; ++s) qf[s] = *(const GAS bf16x8*)(qp + (long)ql * q_rs + 16 * s + 8 * hh);
    f32x16 o0, o1;
#pragma unroll
    for (int i = 0; i < 16; ++i) { o0[i] = 0.f; o1[i] = 0.f; }
    float m_run = -INFINITY, l_run = 0.f;
    const float relbase = (float)(4 * hh - ql - 64);
    const int vq = (lane & 15) >> 2;
    LAS unsigned char* vrd = vbuf + (4 * hh + vq) * VROW + ((lane >> 4) & 1) * 32 + 8 * (lane & 3);
    LAS unsigned char* vwr = vbuf + (lane >> 3) * VROW + (lane & 7) * 16;
    LAS unsigned char* kwr = kbuf + (lane >> 3) * KROW + (lane & 7) * 16;
    LAS unsigned char* krd = kbuf + ql * KROW + 16 * hh;
    const bf16* krow = kp + (long)(32 * t_lo + (lane >> 3)) * kv_rs + 8 * (lane & 7);
    const bf16* vrow = vp + (long)(32 * t_lo + (lane >> 3)) * kv_rs + 8 * (lane & 7);
    v4u kk[4], vv[4];
#pragma unroll
    for (int i4 = 0; i4 < 4; ++i4) kk[i4] = *(const GAS v4u*)(krow + (long)(8 * i4) * kv_rs);
#pragma unroll
    for (int i4 = 0; i4 < 4; ++i4) vv[i4] = *(const GAS v4u*)(vrow + (long)(8 * i4) * kv_rs);
#pragma unroll 1
    for (int TI = t_lo; TI < t_hi; ++TI) {
        krow += 32 * kv_rs; vrow += 32 * kv_rs;
#pragma unroll
        for (int i4 = 0; i4 < 4; ++i4) *(LAS v4u*)(kwr + 8 * i4 * KROW) = kk[i4];
#pragma unroll
        for (int i4 = 0; i4 < 4; ++i4) *(LAS v4u*)(vwr + 8 * i4 * VROW) = vv[i4];
        if (TI + 1 < t_hi) {
#pragma unroll
            for (int i4 = 0; i4 < 4; ++i4) kk[i4] = *(const GAS v4u*)(krow + (long)(8 * i4) * kv_rs);
#pragma unroll
            for (int i4 = 0; i4 < 4; ++i4) vv[i4] = *(const GAS v4u*)(vrow + (long)(8 * i4) * kv_rs);
        }
        bf16x8 kf[4];
#pragma unroll
        for (int ss = 0; ss < 4; ++ss) kf[ss] = *(const LAS bf16x8*)(krd + 32 * ss);
        f32x16 acc;
        if (DIL) {
            const float rb = relbase + (float)(32 * TI);
            const bool edge = (TI == 0) || (TI == nt_total - 1);
#pragma unroll
            for (int i = 0; i < 16; ++i) { const float ar = __builtin_fabsf(rb + (float)((i & 3) + 8 * (i >> 2))); float v = -c2 * ar; if (edge) v = (ar > 64.f) ? -INFINITY : v; acc[i] = v; }
        } else {
#pragma unroll
            for (int i = 0; i < 16; ++i) acc[i] = 0.f;
        }
#pragma unroll
        for (int ss = 0; ss < 4; ++ss) acc = __builtin_amdgcn_mfma_f32_32x32x16_bf16(kf[ss], qf[ss], acc, 0, 0, 0);
        float mx = acc[0];
#pragma unroll
        for (int i = 1; i < 16; ++i) mx = __builtin_fmaxf(mx, acc[i]);
        mx = __builtin_fmaxf(mx, __shfl_xor(mx, 32));
        const float m_new = __builtin_fmaxf(m_run, mx);
        const float alpha = __builtin_amdgcn_exp2f(m_run - m_new);
        m_run = m_new;
        float ps = 0.f;
#pragma unroll
        for (int i = 0; i < 16; ++i) { acc[i] = __builtin_amdgcn_exp2f(acc[i] - m_new); ps += acc[i]; }
        l_run = l_run * alpha + ps;
#pragma unroll
        for (int i = 0; i < 16; ++i) { o0[i] *= alpha; o1[i] *= alpha; }
#pragma unroll
        for (int sk = 0; sk < 2; ++sk) {
            v4u pw; pw.x = cvtpk_s(acc[8 * sk + 0], acc[8 * sk + 1]); pw.y = cvtpk_s(acc[8 * sk + 2], acc[8 * sk + 3]);
            pw.z = cvtpk_s(acc[8 * sk + 4], acc[8 * sk + 5]); pw.w = cvtpk_s(acc[8 * sk + 6], acc[8 * sk + 7]);
            const bf16x8 pf = __builtin_bit_cast(bf16x8, pw);
            const s16x4 a0 = vtr(vrd + (16 * sk) * VROW), a1 = vtr(vrd + (16 * sk + 8) * VROW);
            const s16x4 b0 = vtr(vrd + (16 * sk) * VROW + 64), b1 = vtr(vrd + (16 * sk + 8) * VROW + 64);
            const bf16x8 vf0 = (bf16x8){a0[0], a0[1], a0[2], a0[3], a1[0], a1[1], a1[2], a1[3]};
            const bf16x8 vf1 = (bf16x8){b0[0], b0[1], b0[2], b0[3], b1[0], b1[1], b1[2], b1[3]};
            o0 = __builtin_amdgcn_mfma_f32_32x32x16_bf16(vf0, pf, o0, 0, 0, 0);
            o1 = __builtin_amdgcn_mfma_f32_32x32x16_bf16(vf1, pf, o1, 0, 0, 0);
        }
    }
    const float l_tot = l_run + __shfl_xor(l_run, 32);
    const float inv = 1.0f / l_tot;
    if (lsep != nullptr && hh == 0) lsep[(long)ql * lse_rs] = m_run + __builtin_log2f(l_tot);
    if constexpr (O8) {
        const float is = inv * SC_OP;
        LAS unsigned char* ost = kbuf + ql * KROW + 4 * hh;
#pragma unroll
        for (int g4 = 0; g4 < 4; ++g4) {
            *(LAS unsigned*)(ost + 8 * g4) = pg8::pk4_e4m3(o0[4 * g4 + 0] * is, o0[4 * g4 + 1] * is, o0[4 * g4 + 2] * is, o0[4 * g4 + 3] * is);
            *(LAS unsigned*)(ost + 32 + 8 * g4) = pg8::pk4_e4m3(o1[4 * g4 + 0] * is, o1[4 * g4 + 1] * is, o1[4 * g4 + 2] * is, o1[4 * g4 + 3] * is);
        }
#pragma unroll
        for (int i2 = 0; i2 < 2; ++i2) { const int row = (lane >> 2) + 16 * i2; const v4u w = *(const LAS v4u*)(kbuf + row * KROW + (lane & 3) * 16);
            *(GAS v4u*)((unsigned char*)op + (long)row * o_rs + 16 * (lane & 3)) = w; }
    } else {
    LAS unsigned char* ost = kbuf + ql * KROW + 8 * hh;
#pragma unroll
    for (int g4 = 0; g4 < 4; ++g4) {
        v2u w0, w1;
        w0.x = cvtpk_s(o0[4 * g4 + 0] * inv, o0[4 * g4 + 1] * inv); w0.y = cvtpk_s(o0[4 * g4 + 2] * inv, o0[4 * g4 + 3] * inv);
        w1.x = cvtpk_s(o1[4 * g4 + 0] * inv, o1[4 * g4 + 1] * inv); w1.y = cvtpk_s(o1[4 * g4 + 2] * inv, o1[4 * g4 + 3] * inv);
        *(LAS v2u*)(ost + 16 * g4) = w0; *(LAS v2u*)(ost + 64 + 16 * g4) = w1;
    }
#pragma unroll
    for (int i4 = 0; i4 < 4; ++i4) { const int row = (lane >> 3) + 8 * i4; const v4u w = *(const LAS v4u*)(kbuf + row * KROW + (lane & 7) * 16);
        *(GAS v4u*)(op + (long)row * o_rs + 8 * (lane & 7)) = w; }
    }
}
__device__ __forceinline__ void p_attn_fast(Frame& F, int l) {
    LAS unsigned char* vbuf = F.lds + F.wave * 19200; LAS unsigned char* kbuf = vbuf + 6144;
    const int b = blockIdx.x % 8, widx = (blockIdx.x / 8) * NWAVES + F.wave, nw = (F.G / 8) * NWAVES;
    constexpr int NMEM = NMH * 64, NDIL = NDH * 3 * 64;
    for (int it = widx; it < NMEM + NDIL; it += nw) {
        if (it < NMEM) {
            const int hm = it / 64, blk = it % 64; const long row0 = (long)b * SEQ + 32 * blk;
            const bf16* kp = F.KVM + (size_t)(b * MEMT) * 1024 + 512 * l + 64 * hm;
            attn_item<false>(F.H + row0 * HW + H_QM + 64 * hm, HW, kp, kp + 256, 1024, 0, 8, 8, 0.f,
                                   F.MIX + row0 * DM + 768 + 64 * hm, DM, nullptr, 0, kbuf, vbuf, F.lane);
        } else {
            const int j = it - NMEM, h = j / 192, p = (j % 192) / 64, blk = j % 64;
            const int d = (p == 0) ? 1 : (p == 1 ? 4 : 16), L = SEQ / d, nb = L / 32, r = blk / nb, n = blk % nb;
            const long rowq = (long)b * SEQ + (long)(32 * n) * d + r, rowk = (long)b * SEQ + (long)(32 * n - 64) * d + r;
            const int t_lo = (n >= 2) ? 0 : 2 - n, t_hi = (n + 3 <= nb) ? 5 : nb + 2 - n;
            const float slope = __builtin_exp2f(-8.0f * (float)(h + 1) / (float)NDH);
            attn_item<true, OP8>(F.H + rowq * HW + H_Q + 64 * h, (long)d * HW, F.H + rowk * HW + H_K + 64 * h, F.H + rowk * HW + H_V + 64 * h, (long)d * HW, t_lo, t_hi, 5, slope * (float)d * LOG2E,
                                  OP8 ? (bf16*)((unsigned char*)F.OP + ((size_t)p * T + rowq) * 384 + 64 * h) : F.OP + ((size_t)p * T + rowq) * 384 + 64 * h, (long)d * 384, F.LSE + ((size_t)p * T + rowq) * 6 + h, (long)d * 6, kbuf, vbuf, F.lane);
        }
    }
    if (widx >= 128 && SK(1)) {
        LAS float* cscr = (LAS float*)vbuf;
        const int first = atail_first(l), w0 = b * 128 + (widx - 128);
        for (int j = 0; j < ATT_TAIL; ++j) conv_item(F, first + w0 + j * 1024, cscr);
    }
}

__device__ __forceinline__ void p_merge_conv(Frame& F, int l) {
    const int gw = F.vcu * NWAVES + F.wave, NGW = F.G * NWAVES;
    const float* cw = F.conv_w + (size_t)l * 3 * CONVC;
    for (int row = gw; row < T; row += NGW) {
        const int t = row % SEQ;
        if (F.lane < 48) {
            const int c0 = F.lane * 8;
            const bf16* hr = F.H + (size_t)row * HW;
            const v4u z = (v4u){0u, 0u, 0u, 0u};
            const v4u um = (t > 0) ? *(const GAS v4u*)(hr - HW + H_U + c0) : z, u0 = *(const GAS v4u*)(hr + H_U + c0), up = (t < SEQ - 1) ? *(const GAS v4u*)(hr + HW + H_U + c0) : z;
            const v4u bg = *(const GAS v4u*)(hr + H_BG + c0);
            float w0[8], w1[8], w2[8];
#pragma unroll
            for (int i = 0; i < 8; ++i) { w0[i] = cw[c0 + i]; w1[i] = cw[CONVC + c0 + i]; w2[i] = cw[2 * CONVC + c0 + i]; }
            v4u o;
#pragma unroll
            for (int i = 0; i < 4; ++i) {
                const float ulo = w0[2 * i] * bflo(um[i]) + w1[2 * i] * bflo(u0[i]) + w2[2 * i] * bflo(up[i]);
                const float uhi = w0[2 * i + 1] * bfhi(um[i]) + w1[2 * i + 1] * bfhi(u0[i]) + w2[2 * i + 1] * bfhi(up[i]);
                o[i] = pk2(bflo(bg[i]) * ulo, bfhi(bg[i]) * uhi);
            }
            *(GAS v4u*)(F.MIX + (size_t)row * DM + c0) = o;
            const int h = F.lane >> 3;
            const float l0 = F.LSE[((size_t)0 * T + row) * 6 + h], l1 = F.LSE[((size_t)1 * T + row) * 6 + h], l2 = F.LSE[((size_t)2 * T + row) * 6 + h];
            const float mx = __builtin_fmaxf(l0, __builtin_fmaxf(l1, l2));
            float e0 = __builtin_amdgcn_exp2f(l0 - mx), e1 = __builtin_amdgcn_exp2f(l1 - mx), e2 = __builtin_amdgcn_exp2f(l2 - mx);
            const float inv = 1.0f / (e0 + e1 + e2); e0 *= inv; e1 *= inv; e2 *= inv;
            v4u od;
            if (OP8) { typedef float f32x2 __attribute__((ext_vector_type(2)));
                const unsigned char* ob = (const unsigned char*)F.OP + (size_t)row * 384 + c0;
                const v2u a0 = *(const GAS v2u*)ob, a1 = *(const GAS v2u*)(ob + (size_t)T * 384), a2 = *(const GAS v2u*)(ob + (size_t)2 * T * 384);
                e0 *= 1.f / SC_OP; e1 *= 1.f / SC_OP; e2 *= 1.f / SC_OP;
#pragma unroll
                for (int i = 0; i < 4; ++i) { const int wsel = i >> 1; const bool hi = (i & 1) != 0;
                    const f32x2 p0 = hi ? __builtin_amdgcn_cvt_pk_f32_fp8((int)a0[wsel], true) : __builtin_amdgcn_cvt_pk_f32_fp8((int)a0[wsel], false);
                    const f32x2 p1 = hi ? __builtin_amdgcn_cvt_pk_f32_fp8((int)a1[wsel], true) : __builtin_amdgcn_cvt_pk_f32_fp8((int)a1[wsel], false);
                    const f32x2 p2 = hi ? __builtin_amdgcn_cvt_pk_f32_fp8((int)a2[wsel], true) : __builtin_amdgcn_cvt_pk_f32_fp8((int)a2[wsel], false);
                    od[i] = pk2(e0 * p0.x + e1 * p1.x + e2 * p2.x, e0 * p0.y + e1 * p1.y + e2 * p2.y); } }
            else { const v4u a0 = *(const GAS v4u*)(F.OP + ((size_t)0 * T + row) * 384 + c0), a1 = *(const GAS v4u*)(F.OP + ((size_t)1 * T + row) * 384 + c0), a2 = *(const GAS v4u*)(F.OP + ((size_t)2 * T + row) * 384 + c0);
#pragma unroll
            for (int i = 0; i < 4; ++i) od[i] = pk2(e0 * bflo(a0[i]) + e1 * bflo(a1[i]) + e2 * bflo(a2[i]), e0 * bfhi(a0[i]) + e1 * bfhi(a1[i]) + e2 * bfhi(a2[i])); }
            *(GAS v4u*)(F.MIX + (size_t)row * DM + 384 + c0) = od;
        }
    }
}

__device__ __forceinline__ void p_norm_router(Frame& F, int l) {
    LAS float* wl = (LAS float*)F.lds;
    const float* wr = F.w_router + (size_t)l * DM * NE;
    const float* g = F.norm_ffn + (size_t)l * DM;
    { f32x4 wv[8]; float gv[8];
#pragma unroll
      for (int k = 0; k < 8; ++k) { const int i4 = F.tid + 512 * k; wv[k] = *(const GAS f32x4*)(wr + 4 * i4); gv[k] = g[i4 >> 2]; }
#pragma unroll
      for (int k = 0; k < 8; ++k) { const int i4 = F.tid + 512 * k, d = i4 >> 2, e0 = (i4 & 3) * 4;
          wl[(e0 + 0) * DM + d] = wv[k].x * gv[k]; wl[(e0 + 1) * DM + d] = wv[k].y * gv[k]; wl[(e0 + 2) * DM + d] = wv[k].z * gv[k]; wl[(e0 + 3) * DM + d] = wv[k].w * gv[k]; } }
    __syncthreads();
    const int gw = F.vcu * NWAVES + F.wave, NGW = F.G * NWAVES;
    const bool b5 = (F.lane & 32) != 0, b4 = (F.lane & 16) != 0, b3 = (F.lane & 8) != 0, b2 = (F.lane & 4) != 0, b1 = (F.lane & 2) != 0;
    v2u vn[2][4];
    if (gw < T / 2) {
#pragma unroll
        for (int r = 0; r < 2; ++r) { const GAS v2u* xr = (const GAS v2u*)(F.X1B + (size_t)(2 * gw + r) * DM) + F.lane;
#pragma unroll
            for (int j = 0; j < 4; ++j) vn[r][j] = xr[64 * j]; }
    }
    for (int pr = gw; pr < T / 2; pr += NGW) {
        const int row0 = 2 * pr;
        f32x4 v[2][4];
#pragma unroll
        for (int r = 0; r < 2; ++r)
#pragma unroll
            for (int j = 0; j < 4; ++j) { v[r][j].x = bflo(vn[r][j].x); v[r][j].y = bfhi(vn[r][j].x); v[r][j].z = bflo(vn[r][j].y); v[r][j].w = bfhi(vn[r][j].y); }
        float ssum[2];
#pragma unroll
        for (int r = 0; r < 2; ++r) { const GAS f32x4* sp = (const GAS f32x4*)(F.SS1 + (size_t)(row0 + r) * 16); const f32x4 p0 = sp[0], p1 = sp[1], p2 = sp[2], p3 = sp[3];
            ssum[r] = ((((p0.x + p0.y) + (p0.z + p0.w)) + ((p1.x + p1.y) + (p1.z + p1.w))) + (((p2.x + p2.y) + (p2.z + p2.w)) + ((p3.x + p3.y) + (p3.z + p3.w)))); }
        const float r0 = 1.0f / sqrtf(ssum[0] * (1.f / DM) + RMS_EPS), r1 = 1.0f / sqrtf(ssum[1] * (1.f / DM) + RMS_EPS);
        if (pr + NGW < T / 2) {
#pragma unroll
            for (int r = 0; r < 2; ++r) { const GAS v2u* xr = (const GAS v2u*)(F.X1B + (size_t)(2 * (pr + NGW) + r) * DM) + F.lane;
#pragma unroll
                for (int j = 0; j < 4; ++j) vn[r][j] = xr[64 * j]; }
        }
        float lg[32];
        LAS float* wlp = wl + 4 * F.lane; asm volatile("" : "+v"(wlp));
#pragma unroll
        for (int e = 0; e < NE; ++e) { float a0 = 0.f, a1 = 0.f;
#pragma unroll
            for (int j = 0; j < 4; ++j) { const f32x4 w = *(const LAS f32x4*)(wlp + e * DM + 256 * j);
                a0 = __builtin_fmaf(v[0][j].x, w.x, a0); a0 = __builtin_fmaf(v[0][j].y, w.y, a0); a0 = __builtin_fmaf(v[0][j].z, w.z, a0); a0 = __builtin_fmaf(v[0][j].w, w.w, a0);
                a1 = __builtin_fmaf(v[1][j].x, w.x, a1); a1 = __builtin_fmaf(v[1][j].y, w.y, a1); a1 = __builtin_fmaf(v[1][j].z, w.z, a1); a1 = __builtin_fmaf(v[1][j].w, w.w, a1); }
            asm volatile("" : "+v"(wlp), "+v"(a0), "+v"(a1)); lg[e] = a0; lg[16 + e] = a1; }
        if (F.lane == 0) { F.RS1[row0] = r0; F.RS1[row0 + 1] = r1; }
#pragma unroll
        for (int k = 0; k < 16; ++k) { const float keep = b5 ? lg[16 + k] : lg[k], send = b5 ? lg[k] : lg[16 + k]; lg[k] = keep + __shfl_xor(send, 32); }
#pragma unroll
        for (int k = 0; k < 8; ++k) { const float keep = b4 ? lg[8 + k] : lg[k], send = b4 ? lg[k] : lg[8 + k]; lg[k] = keep + __shfl_xor(send, 16); }
#pragma unroll
        for (int k = 0; k < 4; ++k) { const float keep = b3 ? lg[4 + k] : lg[k], send = b3 ? lg[k] : lg[4 + k]; lg[k] = keep + __shfl_xor(send, 8); }
#pragma unroll
        for (int k = 0; k < 2; ++k) { const float keep = b2 ? lg[2 + k] : lg[k], send = b2 ? lg[k] : lg[2 + k]; lg[k] = keep + __shfl_xor(send, 4); }
        { const float keep = b1 ? lg[1] : lg[0], send = b1 ? lg[0] : lg[1]; lg[0] = keep + __shfl_xor(send, 2); }
        float lgt = (lg[0] + __shfl_xor(lg[0], 1)) * (b5 ? r1 : r0);
        float mx = lgt;
#pragma unroll
        for (int m = 2; m <= 16; m <<= 1) mx = __builtin_fmaxf(mx, __shfl_xor(mx, m));
        const float ex = __expf(lgt - mx); float sum = ex;
#pragma unroll
        for (int m = 2; m <= 16; m <<= 1) sum += __shfl_xor(sum, m);
        const int e = (b4 ? 8 : 0) + (b3 ? 4 : 0) + (b2 ? 2 : 0) + (b1 ? 1 : 0);
        const int row = row0 + (b5 ? 1 : 0), bb = row / SEQ, t = row % SEQ;
        if ((F.lane & 1) == 0) F.AFFT[((size_t)bb * NE + e) * SEQ + t] = ex / sum;
    }
    __syncthreads();
}

constexpr int RW_RS = 2064;
__device__ __forceinline__ void p_router_mfma(Frame& F, int l) {
    LAS unsigned char* WH = F.lds; LAS unsigned char* WL = F.lds + 16 * RW_RS; LAS f32x4* XCH = (LAS f32x4*)(F.lds + 32 * RW_RS);
    const float* wr = F.w_router + (size_t)l * DM * NE;
    const float* g = F.norm_ffn + (size_t)l * DM;
    { f32x4 wa[4], wb[4]; float ga[4], gb[4];
#pragma unroll
      for (int k = 0; k < 4; ++k) { const int c = F.tid + 512 * k, dp = c >> 2, e0 = (c & 3) * 4;
          wa[k] = *(const GAS f32x4*)(wr + (size_t)(2 * dp) * NE + e0); wb[k] = *(const GAS f32x4*)(wr + (size_t)(2 * dp + 1) * NE + e0); ga[k] = g[2 * dp]; gb[k] = g[2 * dp + 1]; }
#pragma unroll
      for (int k = 0; k < 4; ++k) { const int c = F.tid + 512 * k, dp = c >> 2, e0 = (c & 3) * 4;
#pragma unroll
          for (int j = 0; j < 4; ++j) { const float va = wa[k][j] * ga[k], vb = wb[k][j] * gb[k];
              const unsigned ha = f2bf(va), hb = f2bf(vb);
              const float ra = va - __builtin_bit_cast(float, ha << 16), rb = vb - __builtin_bit_cast(float, hb << 16);
              *(LAS unsigned*)(WH + (e0 + j) * RW_RS + 4 * dp) = ha | (hb << 16);
              *(LAS unsigned*)(WL + (e0 + j) * RW_RS + 4 * dp) = f2bf(ra) | (f2bf(rb) << 16); } } }
    __syncthreads();
    int tid_ = F.tid; asm volatile("" : "+v"(tid_));
    const int lane = tid_ & 63, tile = F.wave >> 1, kh = F.wave & 1, r16 = lane & 15, kq = lane >> 4;
    for (int blk = F.vcu; blk < T / 64; blk += F.G) {
        const int row0 = blk * 64 + tile * 16;
        const bf16* xr = F.X1B + (size_t)(row0 + r16) * DM + 512 * kh + 8 * kq;
        bf16x8 af[16];
#pragma unroll
        for (int s_ = 0; s_ < 16; ++s_) af[s_] = *(const GAS bf16x8*)(xr + 32 * s_);
        float rsum; { const f32x4 pp = *(const GAS f32x4*)(F.SS1 + (size_t)(row0 + (lane >> 2)) * 16 + 4 * (lane & 3)); rsum = (pp.x + pp.y) + (pp.z + pp.w); }
        rsum += __shfl_xor(rsum, 1); rsum += __shfl_xor(rsum, 2);
        const float rrow = 1.0f / sqrtf(rsum * (1.f / DM) + RMS_EPS);
        f32x4 acc = (f32x4){0.f, 0.f, 0.f, 0.f};
        const LAS unsigned char* bh = WH + r16 * RW_RS + (512 * kh + 8 * kq) * 2; const LAS unsigned char* bl = WL + r16 * RW_RS + (512 * kh + 8 * kq) * 2;
#pragma unroll
        for (int s_ = 0; s_ < 16; ++s_) {
            const bf16x8 fh = *(const LAS bf16x8*)(bh + 64 * s_), fl = *(const LAS bf16x8*)(bl + 64 * s_);
            acc = __builtin_amdgcn_mfma_f32_16x16x32_bf16(af[s_], fh, acc, 0, 0, 0);
            acc = __builtin_amdgcn_mfma_f32_16x16x32_bf16(af[s_], fl, acc, 0, 0, 0);
        }
        if (kh == 1) XCH[tile * 64 + lane] = acc;
        __syncthreads();
        if (kh == 0) {
            acc = acc + XCH[tile * 64 + lane];
            float rs4[4];
#pragma unroll
            for (int j = 0; j < 4; ++j) rs4[j] = __shfl(rrow, 4 * (4 * kq + j));
            f32x4 aff;
#pragma unroll
            for (int j = 0; j < 4; ++j) {
                const float lg = acc[j] * rs4[j];
                float mx = lg;
#pragma unroll
                for (int m = 1; m <= 8; m <<= 1) mx = __builtin_fmaxf(mx, __shfl_xor(mx, m));
                const float ex = __expf(lg - mx); float sm = ex;
#pragma unroll
                for (int m = 1; m <= 8; m <<= 1) sm += __shfl_xor(sm, m);
                aff[j] = ex / sm;
            }
            const int rowa = row0 + 4 * kq, bb = rowa / SEQ, t = rowa % SEQ;
            *(GAS f32x4*)(F.AFFT + ((size_t)bb * NE + r16) * SEQ + t) = aff;
            if (r16 == 0) *(GAS f32x4*)(F.RS1 + rowa) = (f32x4){rs4[0], rs4[1], rs4[2], rs4[3]};
        }
        __syncthreads();
    }
}

__device__ __forceinline__ void p_topk_pair(Frame& F, int b, int e, LAS int* lidx, LAS float* lrs, bool writer) {
    LAS unsigned* cnt = (LAS unsigned*)F.lds;
    LAS unsigned* tab = (LAS unsigned*)(F.lds + 256);
    {
        const float* src = F.AFFT + (size_t)(b * NE + e) * SEQ;
        unsigned x[4];
#pragma unroll
        for (int i = 0; i < 4; ++i) x[i] = __builtin_bit_cast(unsigned, src[i * 512 + F.tid]);
        float rs1v[4];
#pragma unroll
        for (int i = 0; i < 4; ++i) rs1v[i] = F.RS1[(size_t)b * SEQ + i * 512 + F.tid];
        unsigned prefix = 0u;
#pragma unroll 1
        for (int ps = 0; ps < 16; ++ps) {
            const int sh = 30 - 2 * ps;
            const unsigned c1 = prefix | (1u << sh), c2 = prefix | (2u << sh), c3 = prefix | (3u << sh);
            unsigned n1 = 0u, n2 = 0u, n3 = 0u;
#pragma unroll
            for (int i = 0; i < 4; ++i) { n1 += (unsigned)__builtin_popcountll(__ballot(x[i] >= c1)); n2 += (unsigned)__builtin_popcountll(__ballot(x[i] >= c2)); n3 += (unsigned)__builtin_popcountll(__ballot(x[i] >= c3)); }
            const int par = (ps & 1) * 24;
            if (F.lane == 0) { cnt[par + F.wave] = n1; cnt[par + 8 + F.wave] = n2; cnt[par + 16 + F.wave] = n3; }
            __syncthreads();
            unsigned t1 = 0u, t2 = 0u, t3 = 0u;
#pragma unroll
            for (int w = 0; w < 8; ++w) { t1 += cnt[par + w]; t2 += cnt[par + 8 + w]; t3 += cnt[par + 16 + w]; }
            if (t3 >= (unsigned)CAP) prefix = c3; else if (t2 >= (unsigned)CAP) prefix = c2; else if (t1 >= (unsigned)CAP) prefix = c1;
        }
        unsigned long long bq[4], bs[4];
#pragma unroll
        for (int i = 0; i < 4; ++i) { const unsigned long long bg = __ballot(x[i] > prefix); bq[i] = __ballot(x[i] == prefix);
            if (F.lane == 0) { tab[i * 8 + F.wave] = (unsigned)__builtin_popcountll(bg); tab[32 + i * 8 + F.wave] = (unsigned)__builtin_popcountll(bq[i]); } }
        __syncthreads();
        unsigned gtot = 0u;
#pragma unroll
        for (int j = 0; j < 32; ++j) gtot += tab[j];
        const unsigned need = (unsigned)CAP - gtot;
        unsigned run = 0u, eqb[4];
#pragma unroll
        for (int j = 0; j < 32; ++j) { const unsigned v = tab[32 + j];
#pragma unroll
            for (int i = 0; i < 4; ++i) if (j == i * 8 + F.wave) eqb[i] = run;
            run += v; }
        bool sel[4];
#pragma unroll
        for (int i = 0; i < 4; ++i) {
            const unsigned rk = eqb[i] + __builtin_amdgcn_mbcnt_hi((unsigned)(bq[i] >> 32), __builtin_amdgcn_mbcnt_lo((unsigned)bq[i], 0u));
            sel[i] = (x[i] > prefix) || (x[i] == prefix && rk < need);
            bs[i] = __ballot(sel[i]);
            if (F.lane == 0) tab[64 + i * 8 + F.wave] = (unsigned)__builtin_popcountll(bs[i]);
        }
        __syncthreads();
        run = 0u; unsigned selb[4];
#pragma unroll
        for (int j = 0; j < 32; ++j) { const unsigned v = tab[64 + j];
#pragma unroll
            for (int i = 0; i < 4; ++i) if (j == i * 8 + F.wave) selb[i] = run;
            run += v; }
#pragma unroll
        for (int i = 0; i < 4; ++i) {
            const int t = i * 512 + F.tid, row = b * SEQ + t;
            const unsigned slot = selb[i] + __builtin_amdgcn_mbcnt_hi((unsigned)(bs[i] >> 32), __builtin_amdgcn_mbcnt_lo((unsigned)bs[i], 0u));
            if (sel[i]) { lidx[slot] = row; lrs[slot] = rs1v[i] * (GU8 ? 1.f / (SC_X1 * SC_WGU) : 1.f); if (writer) F.GROW[(size_t)e * ER + b * CAP + slot] = __builtin_bit_cast(float, x[i]) * ((DN8 ? 1.f / (SC_HID * SC_WDN) : 1.f) * (Y8 ? SC_Y : 1.f)); }
            if (writer) F.INV[(size_t)row * NE + e] = (short)(sel[i] ? (int)slot : -1);
        }
        __syncthreads();
    }
}

template <bool YF8>
__device__ __forceinline__ void p_combine_norm(Frame& F, int l) {
    const int gw = F.vcu * NWAVES + F.wave, NGW = F.G * NWAVES;
    const bf16* Y = F.XG;
    const GAS f32x4* gr = (const GAS f32x4*)F.norm_final + F.lane;
    for (int pr = gw; pr < T / 2; pr += NGW) {
        typedef float f32x2 __attribute__((ext_vector_type(2)));
        v2u xv[2][4]; typename std::conditional<YF8, unsigned, v2u>::type yv[2][4][4]; float ysc[2][4]; unsigned rest[2]; int invr[2];
#pragma unroll
        for (int q = 0; q < 2; ++q) {
            const int row = pr + q * (T / 2), b = row / SEQ;
            const GAS v2u* xr = (const GAS v2u*)(F.X1B + (size_t)row * DM) + F.lane;
#pragma unroll
            for (int j = 0; j < 4; ++j) xv[q][j] = xr[64 * j];
            invr[q] = (int)F.INV[(size_t)row * NE + (F.lane & 15)];
            unsigned m = (unsigned)__ballot(invr[q] >= 0) & 0xffffu;
#pragma unroll
            for (int k = 0; k < 4; ++k) {
                const bool has = m != 0u; const int e = has ? __builtin_ctz(m) : 0; m &= m - 1u;
                const int r = has ? __builtin_amdgcn_readlane(invr[q], e) : 0;
                ysc[q][k] = has ? (YF8 ? 1.f / SC_Y : 1.f) : 0.f;
                if constexpr (YF8) { const GAS unsigned* yr = (const GAS unsigned*)((const unsigned char*)Y + ((size_t)e * ER + b * CAP + r) * DM) + F.lane;
#pragma unroll
                    for (int j = 0; j < 4; ++j) yv[q][k][j] = yr[64 * j]; }
                else { const GAS v2u* yr = (const GAS v2u*)(Y + ((size_t)e * ER + b * CAP + r) * DM) + F.lane;
#pragma unroll
                    for (int j = 0; j < 4; ++j) yv[q][k][j] = yr[64 * j]; }
            }
            rest[q] = m;
        }
#pragma unroll
        for (int q = 0; q < 2; ++q) {
            const int row = pr + q * (T / 2), b = row / SEQ;
            f32x4 v[4];
#pragma unroll
            for (int j = 0; j < 4; ++j) { v[j].x = bflo(xv[q][j].x); v[j].y = bfhi(xv[q][j].x); v[j].z = bflo(xv[q][j].y); v[j].w = bfhi(xv[q][j].y); }
#pragma unroll
            for (int k = 0; k < 4; ++k)
#pragma unroll
                for (int j = 0; j < 4; ++j) { const float sc = ysc[q][k];
                    if constexpr (YF8) { const unsigned w = yv[q][k][j]; const f32x2 lo = __builtin_amdgcn_cvt_pk_f32_fp8((int)w, false), hi = __builtin_amdgcn_cvt_pk_f32_fp8((int)w, true);
                        v[j].x += sc * lo.x; v[j].y += sc * lo.y; v[j].z += sc * hi.x; v[j].w += sc * hi.y; }
                    else { const v2u w = yv[q][k][j]; v[j].x += sc * bflo(w.x); v[j].y += sc * bfhi(w.x); v[j].z += sc * bflo(w.y); v[j].w += sc * bfhi(w.y); } }
            unsigned m = rest[q];
            while (m != 0u) {
                const int e = __builtin_ctz(m); m &= m - 1u; const int r = __builtin_amdgcn_readlane(invr[q], e);
                if constexpr (YF8) { const GAS unsigned* yr = (const GAS unsigned*)((const unsigned char*)Y + ((size_t)e * ER + b * CAP + r) * DM) + F.lane;
#pragma unroll
                    for (int j = 0; j < 4; ++j) { const unsigned w = yr[64 * j]; const f32x2 lo = __builtin_amdgcn_cvt_pk_f32_fp8((int)w, false), hi = __builtin_amdgcn_cvt_pk_f32_fp8((int)w, true);
                        v[j].x += (1.f / SC_Y) * lo.x; v[j].y += (1.f / SC_Y) * lo.y; v[j].z += (1.f / SC_Y) * hi.x; v[j].w += (1.f / SC_Y) * hi.y; } }
                else { const GAS v2u* yr = (const GAS v2u*)(Y + ((size_t)e * ER + b * CAP + r) * DM) + F.lane;
#pragma unroll
                for (int j = 0; j < 4; ++j) { const v2u w = yr[64 * j]; v[j].x += bflo(w.x); v[j].y += bfhi(w.x); v[j].z += bflo(w.y); v[j].w += bfhi(w.y); } }
            }
            float s = 0.f;
#pragma unroll
            for (int j = 0; j < 4; ++j) s += (v[j].x * v[j].x + v[j].y * v[j].y) + (v[j].z * v[j].z + v[j].w * v[j].w);
            const float rr = 1.0f / sqrtf(wave_sum(s) * (1.f / DM) + RMS_EPS);
            if (l + 1 < NLAYER) {
                GAS unsigned long long* o8 = (GAS unsigned long long*)(F.XB + (size_t)row * DM) + F.lane;
#pragma unroll
                for (int j = 0; j < 4; ++j) o8[64 * j] = (unsigned long long)pk2(v[j].x, v[j].y) | ((unsigned long long)pk2(v[j].z, v[j].w) << 32);
                if (F.lane == 0) { F.RS0[row] = rr; if (IN8) F.RS0S[row] = rr * (1.f / (SC_XB * SC_WIN)); }
                if (IN8) { GAS unsigned* o4 = (GAS unsigned*)(F.XB8 + (size_t)row * DM) + F.lane;
#pragma unroll
                    for (int j = 0; j < 4; ++j) o4[64 * j] = pg8::pk4_e4m3(v[j].x * SC_XB, v[j].y * SC_XB, v[j].z * SC_XB, v[j].w * SC_XB); }
            } else {
                GAS f32x4* orow = (GAS f32x4*)(F.out + (size_t)row * DM) + F.lane;
#pragma unroll
                for (int j = 0; j < 4; ++j) __builtin_nontemporal_store(v[j] * rr * gr[64 * j], orow + 64 * j);
            }
        }
    }
}

struct Args { const float* in[14]; float* out; unsigned char* ws; int ph_lo, ph_hi, li, pad; };
constexpr int NPHASE = 1 + 9 * NLAYER;
template <class Tp> __device__ __forceinline__ Tp* as_global(Tp* p) { return (Tp*)(GAS Tp*)p; }
__device__ __forceinline__ void build_frame(Frame& F) {
    extern __shared__ __attribute__((aligned(16))) unsigned char lds[];
    const CAS Args* A = (const CAS Args*)__builtin_amdgcn_kernarg_segment_ptr();
    asm volatile("" : "+s"(A));
    int tid = threadIdx.x; asm volatile("" : "+v"(tid));
    F.lds = (LAS unsigned char*)lds;
    F.tid = tid; F.lane = tid & 63; F.wave = __builtin_amdgcn_readfirstlane(tid >> 6);
    F.G = gridDim.x; { const int bx = blockIdx.x; F.vcu = (F.G % 8 == 0) ? (bx % 8) * (F.G / 8) + bx / 8 : bx; }
    unsigned char* ws = as_global(A->ws);
    F.x = as_global(A->in[0]); F.mem = as_global(A->in[1]); F.mem_norm = as_global(A->in[2]); F.norm_mix = as_global(A->in[3]); F.w_in = as_global(A->in[4]); F.conv_w = as_global(A->in[5]); F.w_mem_kv = as_global(A->in[6]);
    F.w_out = as_global(A->in[7]); F.norm_ffn = as_global(A->in[8]); F.w_router = as_global(A->in[9]); F.w_gate = as_global(A->in[10]); F.w_up = as_global(A->in[11]); F.w_down = as_global(A->in[12]); F.norm_final = as_global(A->in[13]);
    F.out = as_global(A->out);
    F.WIN = (bf16*)(ws + WS_WIN); F.WKV = (bf16*)(ws + WS_WKV); F.WOUT = (bf16*)(ws + WS_WOUT); F.WGU = (bf16*)(ws + WS_WGU); F.WDN = (bf16*)(ws + WS_WDN);
    F.XB = (bf16*)(ws + WS_XB); F.X1B = (bf16*)(ws + WS_X1B); F.H = (bf16*)(ws + WS_H); F.OP = (bf16*)(ws + WS_OP); F.MIX = (bf16*)(ws + WS_MIX); F.MEMN = (bf16*)(ws + WS_MEMN); F.KVM = (bf16*)(ws + WS_KVM);
    F.XG = (bf16*)(ws + WS_XG); F.HID = (bf16*)(ws + WS_HID); F.LSE = (float*)(ws + WS_LSE); F.AFFT = (float*)(ws + WS_AFFT); F.GROW = (float*)(ws + WS_GROW); F.INV = (short*)(ws + WS_INV); F.IDX = (int*)(ws + WS_IDX); F.RS0 = (float*)(ws + WS_RS0); F.SS1 = (float*)(ws + WS_SS1); F.RS1 = (float*)(ws + WS_RS1); F.RSLOT = (float*)(ws + WS_RSLOT); F.X1F8 = ws + WS_X1F8; F.XB8 = ws + WS_XB8; F.WIN8 = ws + WS_WIN8; F.RS0S = (float*)(ws + WS_RS0S);
}
__device__ __forceinline__ void opp_round() {
    Frame F; build_frame(F);
    volatile LAS unsigned* rd = (volatile LAS unsigned*)(F.lds + MISC_OFF) + 24;
    const unsigned r = rd[0];
    const int first = pool_first((int)r);
    conv_item(F, first + F.vcu * NWAVES + F.wave, (LAS float*)(F.lds + F.wave * CSCR_BYTES));
    __syncthreads();
    if (F.tid == 0) rd[0] = r + 1u;
    __syncthreads();
}
__device__ __forceinline__ void seam_barrier(int k) {
    extern __shared__ __attribute__((aligned(16))) unsigned char lds[];
    const CAS Args* A = (const CAS Args*)__builtin_amdgcn_kernarg_segment_ptr();
    asm volatile("" : "+s"(A));
    XcdBarrier b;
#if ONE_LAUNCH
    b.bar = as_global((unsigned*)g_barrier_words);
#else
    b.bar = (unsigned*)(as_global(A->ws) + WS_CTL) + CW_BAR + A->li * XCD_BAR_WORDS;
#endif
    b.x = xb_xcc_id(); b.st = (volatile LAS unsigned*)((LAS unsigned char*)lds + MISC_OFF) + 8;
    const bool opp = (k <= OPP_LAST_PHASE) && (b.st[16] < (unsigned)OPP_ROUNDS);
    xcd_barrier(b, opp);
    if (opp && b.st[2] != 0u) {
        for (;;) { opp_round();
            if (threadIdx.x == 0) b.st[2] = (b.st[16] < (unsigned)OPP_ROUNDS && xb_ld(&b.bar[XB_XGEN(b.x)]) == b.st[3]) ? 1u : 0u;
            __syncthreads();
            if (b.st[2] == 0u) break; }
        xcd_barrier_wait(b); }
}
__global__ void __launch_bounds__(NWAVES * 64, 2) mega_fwd(Args args) {
    extern __shared__ __attribute__((aligned(16))) unsigned char lds[];
    for (int u = threadIdx.x; u < (LDS_BYTES - LDSCTL_OFF) / 4; u += NWAVES * 64) ((LAS unsigned*)((LAS unsigned char*)lds + LDSCTL_OFF))[u] = 0u;
    __syncthreads();
    const int lo = args.ph_lo, hi = args.ph_hi;
#if ONE_LAUNCH
    if (hi - lo > 1) (void)xcd_barrier_post(as_global((unsigned*)g_barrier_words), (volatile LAS unsigned*)((LAS unsigned char*)lds + MISC_OFF) + 8);
#else
    if (hi - lo > 1) (void)xcd_barrier_post((unsigned*)(args.ws + WS_CTL) + CW_BAR + args.li * XCD_BAR_WORDS, (volatile LAS unsigned*)((LAS unsigned char*)lds + MISC_OFF) + 8);
#endif
#define IN(k) (lo <= (k) && (k) < hi)
#define SEAM(k) do { if ((k) + 1 < hi) for (int rep = 0; rep < NREP(2048); ++rep) seam_barrier(k); } while (0)

    if (IN(0)) { if (SK(1)) for (int rep = 0; rep < NREP(1); ++rep) { Frame F; build_frame(F); p0_prologue(F, 0); } SEAM(0);
                 if (SK(1)) for (int rep = 0; rep < NREP(1); ++rep) { Frame F; build_frame(F); p0_prologue(F, 1); } __syncthreads(); }
#pragma unroll 1
    for (int l = 0; l < NLAYER; ++l) {
        const int pb = 1 + 9 * l;
        if (IN(pb + 0)) {
          if constexpr (IN8) {
            const int bx = (int)blockIdx.x, f0 = (l == 0) ? 96 : 64;
            if (SK(2)) for (int rep = 0; rep < NREP(2); ++rep) { Frame F; build_frame(F);
              pg8::Gemm g{F.XB, F.WIN + (size_t)l * INW * DM, T, INB, DM, 1 << 30, 0, nullptr}; pg8::StaticOrder S; S.init(T, INB, F.G, bx);
              pg8::EpiInB E{F.H, HW, F.RS0, H_U, H_BG};
              pg8::gemm_phase<pg8::EpiInB, pg8::StaticOrder, true, true>(F.lds, g, S, E); }
            if (SK(2) && bx >= f0) for (int rep = 0; rep < NREP(2); ++rep) { Frame F; build_frame(F);
              pg8::Gemm g{(const pg8::bf16_t*)F.XB8, (const pg8::bf16_t*)(F.WIN8 + (size_t)l * INF * DM), T, INF, DM / 2, 1 << 30, 0, nullptr}; pg8::StaticOrder S; S.init(T, INF, 256 - f0, bx - f0);
              pg8::EpiBf16 E{F.H + (H_Q + 128), HW, F.RS0S};
              pg8::gemm_phase<pg8::EpiBf16, pg8::StaticOrder, true, true, false, true>(F.lds, g, S, E); }
            if (SK(4) && l == 0 && bx >= 64 && bx < 96) { Frame F; build_frame(F);
              pg8::Gemm g{F.MEMN, F.WKV, NB * MEMT, 1024, DM, 1 << 30, 0, nullptr}; pg8::StaticOrder S; S.init(NB * MEMT, 1024, 32, bx - 64);
              pg8::EpiBf16 E{F.KVM, 1024, nullptr};
              pg8::gemm_phase<pg8::EpiBf16, pg8::StaticOrder, true, true>(F.lds, g, S, E); }
          } else {
            if (SK(2)) for (int rep = 0; rep < NREP(2); ++rep) { Frame F; build_frame(F);
              pg8::Gemm g{F.XB, F.WIN + (size_t)l * INW * DM, T, INW, DM, 1 << 30, 0, nullptr}; pg8::StaticOrder S; S.init(T, INW, F.G, (int)blockIdx.x);
              pg8::EpiBf16 E{F.H, INW, F.RS0};
              pg8::gemm_phase<pg8::EpiBf16, pg8::StaticOrder, true, true>(F.lds, g, S, E); }
            if (SK(4) && l == 0) { Frame F; build_frame(F);
              pg8::Gemm g{F.MEMN, F.WKV, NB * MEMT, 1024, DM, 1 << 30, 0, nullptr}; pg8::StaticOrder S; S.init(NB * MEMT, 1024, F.G, (int)((blockIdx.x + F.G / 2) % F.G));
              pg8::EpiBf16 E{F.KVM, 1024, nullptr};
              pg8::gemm_phase<pg8::EpiBf16, pg8::StaticOrder, true, true>(F.lds, g, S, E); }
          }
            { const int wg0 = (l == 0) ? DEFER_WG0 : DEFER_WG1, first = defer_first(l);
              if (SK(1) && (int)blockIdx.x >= wg0) { Frame F; build_frame(F);
                LAS float* scr = (LAS float*)(F.lds + F.wave * CSCR_BYTES); const int w0 = ((int)blockIdx.x - wg0) * NWAVES + F.wave;
                for (int j = 0; j < DEFER_PER; ++j) conv_item(F, first + w0 + j * (256 - wg0) * NWAVES, scr); } }
            SEAM(pb + 0);
        }
        if (IN(pb + 1)) { if (SK(8)) for (int rep = 0; rep < NREP(8); ++rep) { Frame F; build_frame(F); p_attn_fast(F, l); } SEAM(pb + 1); }
        if (IN(pb + 2)) { if (SK(16)) for (int rep = 0; rep < NREP(16); ++rep) { Frame F; build_frame(F); p_merge_conv(F, l); } SEAM(pb + 2); }
        if (IN(pb + 3)) {
            if (SK(32)) for (int rep = 0; rep < NREP(32); ++rep) { Frame F; build_frame(F);
            pg8::Gemm g{F.MIX, F.WOUT + (size_t)l * DM * DM, T, DM, DM, 1 << 30, 0, nullptr}; pg8::StaticOrder S; S.init(T, DM, F.G, (int)blockIdx.x);
            pg8::EpiResBf16 E{F.XB, F.X1B, DM, F.SS1, GU8 ? F.X1F8 : nullptr, SC_X1};
            pg8::gemm_phase<pg8::EpiResBf16, pg8::StaticOrder, false, true>(F.lds, g, S, E); }
            SEAM(pb + 3);
        }
        if (IN(pb + 4)) { if (SK(64)) for (int rep = 0; rep < NREP(64); ++rep) { Frame F; build_frame(F); if (ROUTER_MFMA) p_router_mfma(F, l); else p_norm_router(F, l); }
            if (SK(1)) { __syncthreads(); while (((volatile LAS unsigned*)((LAS unsigned char*)lds + MISC_OFF))[24] < (unsigned)(l == 0 ? OPP_A : OPP_ROUNDS)) opp_round(); }
            SEAM(pb + 4); }
        if (IN(pb + 6)) {
            if (SK(256)) for (int rep = 0; rep < NREP(256); ++rep) { Frame F; build_frame(F);
            const int e = F.vcu >> 4, b = F.vcu & 7, pm = e * 8 + b;
            LAS int* lidx = (LAS int*)(F.lds + LDSX_OFF); LAS float* lrs = (LAS float*)(F.lds + LDSX_OFF + 1024);
            if (GU8 && F.wave < 4) {
                const unsigned char* wb = (const unsigned char*)F.WGU + (size_t)l * NE * 2 * FF * DM + (size_t)e * 2 * FF * DM + (size_t)(((F.vcu >> 3) & 1) * 8) * (256 * DM) + (size_t)(F.vcu & 7) * (32 * 1024) + (size_t)(F.wave * 64 + F.lane) * 128;
#pragma unroll
                for (int u = 0; u < 2; ++u) __builtin_amdgcn_global_load_lds((const GAS unsigned*)(wb + (size_t)u * 256 * DM), (LAS unsigned*)(F.lds + RING_BYTES + F.wave * 256), 4, 0, 0); }
            p_topk_pair(F, b, e, lidx, lrs, ((F.vcu >> 3) & 1) == 0);
            pg8::ExpertOrder S; S.init(F.vcu);
            static_assert(GU8 == DN8, "expert GEMMs: both fp8 or both bf16");
            if constexpr (GU8) {
              pg8::Gemm g{(const pg8::bf16_t*)F.X1F8, (const pg8::bf16_t*)((const unsigned char*)F.WGU + (size_t)l * NE * 2 * FF * DM), NE * ER, 2 * FF, DM / 2, ER / 256, (size_t)2 * FF * DM / 2, (const int*)lidx - pm * 256};
              pg8::EpiSwiGLU8 E{(unsigned char*)F.HID, FF, (const float*)lrs - pm * 256, SC_HID};
              pg8::gemm_phase<pg8::EpiSwiGLU8, pg8::ExpertOrder, true, true, true, true>(F.lds, g, S, E); }
            else { pg8::Gemm g{F.X1B, F.WGU + (size_t)l * NE * 2 * FF * DM, NE * ER, 2 * FF, DM, ER / 256, (size_t)2 * FF * DM, (const int*)lidx - pm * 256};
              pg8::EpiSwiGLU E{F.HID, FF, (const float*)lrs - pm * 256};
              pg8::gemm_phase<pg8::EpiSwiGLU, pg8::ExpertOrder, true, true, true>(F.lds, g, S, E); } }
            SEAM(pb + 6);
        }
        if (IN(pb + 7)) {
            if (SK(512)) for (int rep = 0; rep < NREP(512); ++rep) { Frame F; build_frame(F);
            pg8::StaticOrder S; S.init(NE * ER, DM, F.G, (int)blockIdx.x); pg8::EpiBf16 E{F.XG, DM, F.GROW};
            static_assert(!Y8 || DN8, "fp8 Y needs the fp8 down projection");
            if constexpr (DN8) {
              pg8::Gemm g{F.HID, (const pg8::bf16_t*)((const unsigned char*)F.WDN + (size_t)l * NE * DM * FF), NE * ER, DM, FF / 2, ER / 256, (size_t)DM * FF / 2, nullptr};
              if constexpr (Y8) { pg8::EpiF8 E8{(unsigned char*)F.XG, DM, F.GROW}; pg8::gemm_phase<pg8::EpiF8, pg8::StaticOrder, true, true, false, true>(F.lds, g, S, E8); }
              else pg8::gemm_phase<pg8::EpiBf16, pg8::StaticOrder, true, true, false, true>(F.lds, g, S, E); }
            else { pg8::Gemm g{F.HID, F.WDN + (size_t)l * NE * DM * FF, NE * ER, DM, FF, ER / 256, (size_t)DM * FF, nullptr};
              pg8::gemm_phase<pg8::EpiBf16, pg8::StaticOrder, true, true>(F.lds, g, S, E); } }
            SEAM(pb + 7);
        }
        if (IN(pb + 8)) { if (SK(1024)) for (int rep = 0; rep < NREP(1024); ++rep) { Frame F; build_frame(F); p_combine_norm<Y8>(F, l); } SEAM(pb + 8); }
    }
#undef IN
#undef SEAM
#if ONE_LAUNCH
    if (hi - lo > 1) {
        __syncthreads();
        if (threadIdx.x == 0) { unsigned* bar = as_global((unsigned*)g_barrier_words);
            if (xb_add(&bar[XB_EXIT], 1u) + 1u == gridDim.x) {
                for (unsigned j = 0; j < 16; ++j) { __hip_atomic_store(&bar[XB_XCNT(j)], 0u, RLX_AGENT); __hip_atomic_store(&bar[XB_XSUB(j)], 0u, RLX_AGENT); __hip_atomic_store(&bar[XB_XGEN(j)], 0u, RLX_AGENT); }
                __hip_atomic_store(&bar[XB_TOP], 0u, RLX_AGENT); __hip_atomic_store(&bar[XB_TOPGEN], 0u, RLX_AGENT); __hip_atomic_store(&bar[XB_TMO], 0u, RLX_AGENT); __hip_atomic_store(&bar[XB_EXIT], 0u, RLX_AGENT); } }
    }
#endif
}

extern "C" void kernel_launch(void* const* d_in, const int* in_sizes, int n_in, void* d_out, int out_size, void* d_ws, size_t ws_size, hipStream_t stream) {
    static int grid = 0;
    if (grid == 0) {
        if (n_in != 14 || in_sizes[0] != T * DM || out_size != T * DM || ws_size < WS_END) { fprintf(stderr, "kernel_launch: unexpected shapes (n_in %d, in0 %d, out %d, ws %zu); nothing launched\n", n_in, n_in > 0 ? in_sizes[0] : -1, out_size, ws_size); grid = -1; return; }
        int dev = 0, cus = 0;
        if (hipGetDevice(&dev) != hipSuccess || hipDeviceGetAttribute(&cus, hipDeviceAttributeMultiprocessorCount, dev) != hipSuccess) { grid = -1; return; }
        if (hipFuncSetAttribute((const void*)mega_fwd, hipFuncAttributeMaxDynamicSharedMemorySize, LDS_BYTES) != hipSuccess) { fprintf(stderr, "kernel_launch: hipFuncSetAttribute failed\n"); grid = -1; return; }
        (void)hipGetLastError();
        grid = cus;
        if (grid != 256) fprintf(stderr, "kernel_launch: %d CUs; this kernel is laid out for 256\n", grid);
    }
    if (grid < 0) return;
#if !ONE_LAUNCH
    (void)hipMemsetAsync((char*)d_ws + WS_CTL, 0, CTL_ZERO_BYTES, stream);
#endif
    Args a{};
    for (int i = 0; i < 14; ++i) a.in[i] = (const float*)d_in[i];
    a.out = (float*)d_out; a.ws = (unsigned char*)d_ws;
    int li = 0;
    auto mega = [&](int lo, int hi) { a.ph_lo = lo; a.ph_hi = hi; a.li = li++; hipLaunchKernelGGL(mega_fwd, dim3(grid), dim3(NWAVES * 64), LDS_BYTES, stream, a); };
#if ONE_LAUNCH
    mega(0, NPHASE);
#else
    for (int k = 0; k < NPHASE; ++k) mega(k, k + 1);
#endif
}
```
